# Optimizing an MI355X kernel written in HIP

```python
import math
import jax, jax.numpy as jnp
from jax import lax
import numpy as np

D_MODEL = 1024
BATCH = 8
SEQ = 2048
DEPTH = 2

CHUNK = 64
Q_BLOCK = 128
EPS = 1e-6
NEG = -1e30

T5_BUCKETS = 32
T5_MAX_DIST = 128

MLA_HEADS = 8
MLA_NOPE = 64
MLA_ROPE = 32
MLA_V = 64
MLA_QK = MLA_NOPE + MLA_ROPE
MLA_Q_RANK = 384
MLA_KV_RANK = 256
ROPE_THETA = 10000.0

SWA_HEADS = 8
SWA_KV_HEADS = 2
SWA_GROUP = SWA_HEADS // SWA_KV_HEADS
SWA_HEAD_DIM = 64
SWA_WINDOW = 128
SWA_BAND = SWA_WINDOW // CHUNK

CA_HEADS = 16
CA_HEAD_DIM = 64
CA_LEFT_CHUNKS = 8
CA_REL_PAST = 256
CA_REL_SIZE = CA_REL_PAST + CHUNK

PEER_HEADS = 8
PEER_N_KEYS = 128
PEER_N_EXPERTS = PEER_N_KEYS * PEER_N_KEYS
PEER_HALF = 128
PEER_TOPK = 16
PEER_TOKEN_BLOCK = 128

MLA_IN = MLA_Q_RANK + MLA_KV_RANK + MLA_ROPE
SWA_IN = (SWA_HEADS + 2 * SWA_KV_HEADS) * SWA_HEAD_DIM
EVEN_IN = MLA_IN + SWA_IN
EVEN_MIX = MLA_HEADS * MLA_V + SWA_HEADS * SWA_HEAD_DIM
ODD_IN = 3 * CA_HEADS * CA_HEAD_DIM
ODD_MIX = CA_HEADS * CA_HEAD_DIM
N_EVEN = (DEPTH + 1) // 2
N_ODD = DEPTH // 2

kernel_name = "hybrid_mla_swa_chunkattn_peer"


def rms_norm(x, g):
    xf = x.astype(jnp.float32)
    y = xf * lax.rsqrt(jnp.mean(xf * xf, axis=-1, keepdims=True) + EPS) * g.astype(jnp.float32)
    return y.astype(x.dtype)


def apply_rope(x):
    S, R = x.shape[1], x.shape[-1]
    inv = ROPE_THETA ** (-jnp.arange(0, R, 2, dtype=jnp.float32) / R)
    ang = jnp.arange(S, dtype=jnp.float32)[:, None] * inv[None, :]
    cos = jnp.cos(ang)[None, :, None, :]
    sin = jnp.sin(ang)[None, :, None, :]
    x1, x2 = jnp.split(x.astype(jnp.float32), 2, axis=-1)
    return jnp.concatenate([x1 * cos - x2 * sin, x1 * sin + x2 * cos], axis=-1).astype(x.dtype)


def t5_bucket(rel):
    nb = T5_BUCKETS // 2
    max_exact = nb // 2
    ret = jnp.where(rel > 0, nb, 0)
    n = jnp.abs(rel)
    large = max_exact + (jnp.log(jnp.maximum(n, 1).astype(jnp.float32) / max_exact)
                         / math.log(T5_MAX_DIST / max_exact) * (nb - max_exact)).astype(jnp.int32)
    large = jnp.minimum(large, nb - 1)
    return ret + jnp.where(n < max_exact, n, large)


def mla_attention(p, g_cq, w_uq, g_ckv, w_ukv, g_q, g_k):
    B, S, _ = p.shape
    c_q = rms_norm(p[..., :MLA_Q_RANK], g_cq)
    c_kv = rms_norm(p[..., MLA_Q_RANK:MLA_Q_RANK + MLA_KV_RANK], g_ckv)
    k_pe = p[..., MLA_Q_RANK + MLA_KV_RANK:]
    q = jnp.einsum('bsr,rhd->bshd', c_q, w_uq)
    kv = jnp.einsum('bsr,rhd->bshd', c_kv, w_ukv)
    k_nope, v = kv[..., :MLA_NOPE], kv[..., MLA_NOPE:]
    k = jnp.concatenate([k_nope, jnp.broadcast_to(k_pe[:, :, None, :], (B, S, MLA_HEADS, MLA_ROPE))], -1)
    q = rms_norm(q, g_q)
    k = rms_norm(k, g_k)
    q = jnp.concatenate([q[..., :MLA_NOPE], apply_rope(q[..., MLA_NOPE:])], -1)
    k = jnp.concatenate([k[..., :MLA_NOPE], apply_rope(k[..., MLA_NOPE:])], -1)
    scale = MLA_QK ** -0.5
    nqb = S // Q_BLOCK
    qb = q.reshape(B, nqb, Q_BLOCK, MLA_HEADS, MLA_QK).transpose(1, 0, 2, 3, 4)
    key_chunk = jnp.arange(S) // CHUNK

    def block(args):
        qi, idx = args
        s = jnp.einsum('bqhd,bkhd->bhqk', qi, k, preferred_element_type=jnp.float32) * scale
        q_chunk = (idx * Q_BLOCK + jnp.arange(Q_BLOCK)) // CHUNK
        mask = key_chunk[None, :] <= q_chunk[:, None]
        s = jnp.where(mask[None, None], s, NEG)
        pr = jax.nn.softmax(s, axis=-1)
        return jnp.einsum('bhqk,bkhd->bqhd', pr.astype(v.dtype), v)

    o = lax.map(block, (qb, jnp.arange(nqb)))
    return o.transpose(1, 0, 2, 3, 4).reshape(B, S, MLA_HEADS * MLA_V)


def swa_attention(p, g_q, g_k, sinks, t5_table):
    B, S, _ = p.shape
    nq = SWA_HEADS * SWA_HEAD_DIM
    nk = SWA_KV_HEADS * SWA_HEAD_DIM
    q = rms_norm(p[..., :nq].reshape(B, S, SWA_HEADS, SWA_HEAD_DIM), g_q)
    k = rms_norm(p[..., nq:nq + nk].reshape(B, S, SWA_KV_HEADS, SWA_HEAD_DIM), g_k)
    v = p[..., nq + nk:].reshape(B, S, SWA_KV_HEADS, SWA_HEAD_DIM)
    NC = S // CHUNK
    BANDW = (SWA_BAND + 1) * CHUNK
    qc = q.reshape(B, NC, CHUNK, SWA_KV_HEADS, SWA_GROUP, SWA_HEAD_DIM)
    pad = ((0, 0), (SWA_BAND, 0), (0, 0), (0, 0), (0, 0))
    kp = jnp.pad(k.reshape(B, NC, CHUNK, SWA_KV_HEADS, SWA_HEAD_DIM), pad)
    vp = jnp.pad(v.reshape(B, NC, CHUNK, SWA_KV_HEADS, SWA_HEAD_DIM), pad)
    kband = jnp.concatenate([kp[:, j:j + NC] for j in range(SWA_BAND + 1)], axis=2)
    vband = jnp.concatenate([vp[:, j:j + NC] for j in range(SWA_BAND + 1)], axis=2)
    s = jnp.einsum('bncjgd,bnmjd->bnjgcm', qc, kband,
                   preferred_element_type=jnp.float32) * (SWA_HEAD_DIM ** -0.5)
    rel = (jnp.arange(BANDW)[None, :] - SWA_BAND * CHUNK) - jnp.arange(CHUNK)[:, None]
    bias = t5_table[t5_bucket(rel)].astype(jnp.float32).transpose(2, 0, 1)
    s = s + bias.reshape(SWA_KV_HEADS, SWA_GROUP, CHUNK, BANDW)[None, None]
    key_chunk = jnp.arange(NC)[:, None] - SWA_BAND + jnp.arange(BANDW)[None, :] // CHUNK
    s = jnp.where((key_chunk >= 0)[None, :, None, None, None, :], s, NEG)
    sink = jnp.broadcast_to(sinks.astype(jnp.float32).reshape(SWA_KV_HEADS, SWA_GROUP)[None, None, :, :, None, None],
                            s.shape[:-1] + (1,))
    pr = jax.nn.softmax(jnp.concatenate([s, sink], axis=-1), axis=-1)[..., :-1]
    o = jnp.einsum('bnjgcm,bnmjd->bncjgd', pr.astype(vband.dtype), vband)
    return o.reshape(B, S, SWA_HEADS * SWA_HEAD_DIM)


def chunk_attention(p, g_q, g_k, rel_table):
    B, S, _ = p.shape
    w = CA_HEADS * CA_HEAD_DIM
    q = rms_norm(p[..., :w].reshape(B, S, CA_HEADS, CA_HEAD_DIM), g_q)
    k = rms_norm(p[..., w:2 * w].reshape(B, S, CA_HEADS, CA_HEAD_DIM), g_k)
    v = p[..., 2 * w:].reshape(B, S, CA_HEADS, CA_HEAD_DIM)
    NC = S // CHUNK
    L = CA_LEFT_CHUNKS
    BANDW = (L + 1) * CHUNK
    pad = ((0, 0), (L * CHUNK, 0), (0, 0), (0, 0))
    kp = jnp.pad(k, pad)
    vp = jnp.pad(v, pad)
    qc = q.reshape(B, NC, CHUNK, CA_HEADS, CA_HEAD_DIM).transpose(1, 0, 2, 3, 4)
    rel = (jnp.arange(BANDW)[None, :] - L * CHUNK) - jnp.arange(CHUNK)[:, None]
    idx = jnp.clip(rel, -CA_REL_PAST, CHUNK - 1) + CA_REL_PAST
    bias = rel_table[:, idx].astype(jnp.float32)
    scale = CA_HEAD_DIM ** -0.5

    def one(args):
        qi, n = args
        kb = lax.dynamic_slice_in_dim(kp, n * CHUNK, BANDW, axis=1)
        vb = lax.dynamic_slice_in_dim(vp, n * CHUNK, BANDW, axis=1)
        s = jnp.einsum('bqhd,bkhd->bhqk', qi, kb, preferred_element_type=jnp.float32) * scale + bias[None]
        valid = (n * CHUNK - L * CHUNK + jnp.arange(BANDW)) >= 0
        s = jnp.where(valid[None, None, None, :], s, NEG)
        pr = jax.nn.softmax(s, axis=-1)
        return jnp.einsum('bhqk,bkhd->bqhd', pr.astype(vb.dtype), vb)

    o = lax.map(one, (qc, jnp.arange(NC)))
    return o.transpose(1, 0, 2, 3, 4).reshape(B, S, w)


def peer(h, w_query, sub_keys, u_emb, v_emb):
    B, S, D = h.shape
    T = B * S
    xt = h.reshape(T // PEER_TOKEN_BLOCK, PEER_TOKEN_BLOCK, D)

    def block(xb):
        t = xb.shape[0]
        q = jnp.einsum('td,dhpk->thpk', xb, w_query)
        sc = jnp.einsum('thpk,hpnk->thpn', q, sub_keys, preferred_element_type=jnp.float32)
        s1, i1 = lax.top_k(sc[:, :, 0], PEER_TOPK)
        s2, i2 = lax.top_k(sc[:, :, 1], PEER_TOPK)
        cand = (s1[..., :, None] + s2[..., None, :]).reshape(t, PEER_HEADS, PEER_TOPK * PEER_TOPK)
        cand_idx = (i1[..., :, None] * PEER_N_KEYS + i2[..., None, :]).reshape(t, PEER_HEADS, PEER_TOPK * PEER_TOPK)
        top_s, pos = lax.top_k(cand, PEER_TOPK)
        eidx = jnp.take_along_axis(cand_idx, pos, axis=-1)
        g = jax.nn.softmax(top_s, axis=-1)
        u = u_emb[eidx]
        a = jax.nn.gelu(jnp.einsum('thkd,td->thk', u, xb, preferred_element_type=jnp.float32))
        vv = v_emb[eidx]
        return jnp.einsum('thk,thkd->td', (g * a).astype(vv.dtype), vv)

    return lax.map(block, xt).reshape(B, S, D)


def setup_inputs(seed: int = 0) -> dict:
    key = jax.random.key(seed)
    ks = iter(jax.random.split(key, 32))
    nrm = lambda shape, s: jax.random.normal(next(ks), shape, jnp.float32) * s
    gain = lambda shape: 1.0 + 0.02 * jax.random.normal(next(ks), shape, jnp.float32)
    return {
        "x": nrm((BATCH, SEQ, D_MODEL), 1.0),
        "t5_bias": nrm((T5_BUCKETS, SWA_HEADS), 0.5),
        "norm_mix": gain((DEPTH, D_MODEL)),
        "norm_ffn": gain((DEPTH, D_MODEL)),
        "ev_w_in": nrm((N_EVEN, D_MODEL, EVEN_IN), D_MODEL ** -0.5),
        "ev_w_out": nrm((N_EVEN, EVEN_MIX, D_MODEL), 0.5 * EVEN_MIX ** -0.5),
        "mla_g_cq": gain((N_EVEN, MLA_Q_RANK)),
        "mla_w_uq": nrm((N_EVEN, MLA_Q_RANK, MLA_HEADS, MLA_QK), MLA_Q_RANK ** -0.5),
        "mla_g_ckv": gain((N_EVEN, MLA_KV_RANK)),
        "mla_w_ukv": nrm((N_EVEN, MLA_KV_RANK, MLA_HEADS, MLA_NOPE + MLA_V), MLA_KV_RANK ** -0.5),
        "mla_g_q": gain((N_EVEN, MLA_QK)),
        "mla_g_k": gain((N_EVEN, MLA_QK)),
        "swa_g_q": gain((N_EVEN, SWA_HEAD_DIM)),
        "swa_g_k": gain((N_EVEN, SWA_HEAD_DIM)),
        "swa_sinks": nrm((N_EVEN, SWA_HEADS), 0.5),
        "od_w_in": nrm((N_ODD, D_MODEL, ODD_IN), D_MODEL ** -0.5),
        "od_w_out": nrm((N_ODD, ODD_MIX, D_MODEL), 0.5 * ODD_MIX ** -0.5),
        "ca_g_q": gain((N_ODD, CA_HEAD_DIM)),
        "ca_g_k": gain((N_ODD, CA_HEAD_DIM)),
        "ca_rel_bias": nrm((N_ODD, CA_HEADS, CA_REL_SIZE), 0.5),
        "peer_w_query": nrm((DEPTH, D_MODEL, PEER_HEADS, 2, PEER_HALF), D_MODEL ** -0.5),
        "peer_sub_keys": nrm((DEPTH, PEER_HEADS, 2, PEER_N_KEYS, PEER_HALF), PEER_HALF ** -0.5),
        "peer_u": nrm((DEPTH, PEER_N_EXPERTS, D_MODEL), D_MODEL ** -0.5),
        "peer_v": nrm((DEPTH, PEER_N_EXPERTS, D_MODEL), PEER_HEADS ** -0.5),
    }


def reference(x, t5_bias, norm_mix, norm_ffn, ev_w_in, ev_w_out, mla_g_cq, mla_w_uq, mla_g_ckv,
              mla_w_ukv, mla_g_q, mla_g_k, swa_g_q, swa_g_k, swa_sinks, od_w_in, od_w_out,
              ca_g_q, ca_g_k, ca_rel_bias, peer_w_query, peer_sub_keys, peer_u, peer_v):
    for layer in range(DEPTH):
        i = layer // 2
        h = rms_norm(x, norm_mix[layer])
        if layer % 2 == 0:
            proj = jnp.einsum('bsd,de->bse', h, ev_w_in[i])
            o_a = mla_attention(proj[..., :MLA_IN], mla_g_cq[i], mla_w_uq[i], mla_g_ckv[i],
                                mla_w_ukv[i], mla_g_q[i], mla_g_k[i])
            o_b = swa_attention(proj[..., MLA_IN:], swa_g_q[i], swa_g_k[i], swa_sinks[i], t5_bias)
            mix = jnp.einsum('bse,ed->bsd', jnp.concatenate([o_a, o_b], axis=-1), ev_w_out[i])
        else:
            proj = jnp.einsum('bsd,de->bse', h, od_w_in[i])
            o_c = chunk_attention(proj, ca_g_q[i], ca_g_k[i], ca_rel_bias[i])
            mix = jnp.einsum('bse,ed->bsd', o_c, od_w_out[i])
        x = x + mix
        x = x + peer(rms_norm(x, norm_ffn[layer]), peer_w_query[layer], peer_sub_keys[layer],
                     peer_u[layer], peer_v[layer])
    return x
```

```cpp
#include <hip/hip_runtime.h>
#include <cstdio>
#include <cstdint>

#define GAS __attribute__((address_space(1)))
#define LAS __attribute__((address_space(3)))
typedef unsigned short bf16;
typedef short bf16x8 __attribute__((ext_vector_type(8)));
typedef short s16x4 __attribute__((ext_vector_type(4)));
typedef float f32x4 __attribute__((ext_vector_type(4)));
typedef float f32x2 __attribute__((ext_vector_type(2)));
typedef float f32x16 __attribute__((ext_vector_type(16)));
typedef unsigned u32x4 __attribute__((ext_vector_type(4)));
typedef unsigned u32x2 __attribute__((ext_vector_type(2)));
typedef int i32x4 __attribute__((ext_vector_type(4)));
typedef int i32x8 __attribute__((ext_vector_type(8)));
typedef __bf16 bf16v2 __attribute__((ext_vector_type(2)));
typedef _Float16 h16x2 __attribute__((ext_vector_type(2)));

constexpr int T = 16384, D = 1024, SEQ = 2048, NBATCH = 8, NWAVES = 8, NTHR = 512;
constexpr float EPS = 1e-6f, LOG2E = 1.4426950408889634f;

__device__ __forceinline__ unsigned pk2(float lo, float hi) { f32x2 v = {lo, hi}; bf16v2 b = __builtin_convertvector(v, bf16v2); return __builtin_bit_cast(unsigned, b); }
__device__ __forceinline__ float bflo(unsigned w) { return __builtin_bit_cast(float, w << 16); }
__device__ __forceinline__ float bfhi(unsigned w) { return __builtin_bit_cast(float, w & 0xffff0000u); }
__device__ __forceinline__ float fexp2(float x) { return __builtin_amdgcn_exp2f(x); }
#define LDS_WAIT() asm volatile("s_waitcnt lgkmcnt(0)" ::: "memory")
__device__ __forceinline__ unsigned pk4_fp8(float a, float b, float c, float d) {
    a = __builtin_amdgcn_fmed3f(a, -448.f, 448.f); b = __builtin_amdgcn_fmed3f(b, -448.f, 448.f); c = __builtin_amdgcn_fmed3f(c, -448.f, 448.f); d = __builtin_amdgcn_fmed3f(d, -448.f, 448.f);
    int x = __builtin_amdgcn_cvt_pk_fp8_f32(a, b, 0, false); x = __builtin_amdgcn_cvt_pk_fp8_f32(c, d, x, true); return (unsigned)x;
}
__device__ __forceinline__ unsigned pk4_i8(float a, float b, float c, float d) {
    const int ia = (int)__builtin_rintf(__builtin_amdgcn_fmed3f(a, -127.f, 127.f)), ib = (int)__builtin_rintf(__builtin_amdgcn_fmed3f(b, -127.f, 127.f)), ic = (int)__builtin_rintf(__builtin_amdgcn_fmed3f(c, -127.f, 127.f)), id = (int)__builtin_rintf(__builtin_amdgcn_fmed3f(d, -127.f, 127.f));
    return ((unsigned)ia & 0xffu) | (((unsigned)ib & 0xffu) << 8) | (((unsigned)ic & 0xffu) << 16) | ((unsigned)id << 24);
}
constexpr float I8_XS = 32.f, I8_WS = 1024.f;
constexpr float V8_SCALE = 80.f;
constexpr float F8_XS = 16.f, F8_WS = 64.f;
typedef unsigned long long u64;
__device__ __forceinline__ void ssq_add(u64* p, float s) { atomicAdd(p, (u64)(s * 4294967296.f)); }
__device__ __forceinline__ float ssq_get(const u64* p) { return (float)(*p) * 2.3283064365386963e-10f; }

namespace pg8 {
constexpr int BM = 256, BK = 64, HALF = 128, HTB = HALF * BK * 2, STAGE_BYTES = 8 * HTB, NXCD = 8, WGM = 8;
__host__ __device__ __forceinline__ int lds_byte(int r, int c) { const int st = (r >> 4) * 2 + (c >> 5), rr = r & 15, cc = c & 31, ob = rr * 64 + cc * 2; return st * 1024 + (ob ^ (((ob >> 9) & 1) << 5)); }
__host__ __device__ __forceinline__ void stage_rc(int b, int& R, int& C) { const int st = b / 1024, sb = b % 1024, swz = sb ^ (((sb >> 9) & 1) << 5); R = (st >> 1) * 16 + swz / 64; C = (st & 1) * 32 + (swz % 64) / 2; }
__host__ __device__ __forceinline__ int perm32(int rho) { const int n = rho >> 4, i = rho & 15; return 8 * (i >> 2) + 4 * n + (i & 3); }
struct Unit { int pm, pn; };
struct Gemm { const bf16* A; const bf16* Bt; int M, N, K, lda, ldb; };
struct StaticOrder {
    int nM, nN, nwg, G, c;
    __device__ void init(int M, int N, int G_, int c_) { nM = M / BM; nN = N / BM; nwg = nM * nN; G = G_; c = c_; }
    __device__ bool next(int i, Unit& u) const {
        const long L = (long)i * G + c; if (L >= nwg) return false;
        int wgid = (int)L; { const int q = nwg / NXCD, r = nwg % NXCD, xcd = wgid % NXCD, off = wgid / NXCD; wgid = (xcd < r ? xcd * (q + 1) : r * (q + 1) + (xcd - r) * q) + off; }
        const int nig = WGM * nN, gid = wgid / nig, fm = gid * WGM, gsz = (nM - fm) < WGM ? (nM - fm) : WGM;
        u.pm = fm + ((wgid % nig) % gsz); u.pn = (wgid % nig) / gsz; return true;
    }
};
template <class Epi, bool F8 = false, bool I8 = false>
__device__ __forceinline__ void gemm_phase(LAS unsigned char* lds, const Gemm g, const StaticOrder& S, const Epi& E) {
    int tid_ = threadIdx.x; asm volatile("" : "+v"(tid_));
    const int tid = tid_, wid = __builtin_amdgcn_readfirstlane(tid >> 6), lane = tid & 63, wr = wid >> 2, wc = wid & 3, fr = lane & 15, fq = lane >> 4;
    const int K = g.K, nt = K / BK;
    unsigned voffA[2], voffB[2];
#pragma unroll
    for (int i = 0; i < 2; ++i) { int R, C; stage_rc(tid * 16 + i * 8192, R, C); const int Rb = Epi::HEADALIGN ? (64 * (R >> 5) + perm32(R & 31)) : ((R & ~31) + perm32(R & 31));
        voffA[i] = (unsigned)(R * g.lda + C) * 2u; voffB[i] = (unsigned)(Rb * g.ldb + C) * 2u; }
    const size_t kstep = (size_t)(BK * 2);
    const size_t hstepA = (size_t)HALF * g.lda * 2, hstepB = (size_t)(Epi::HEADALIGN ? 32 : HALF) * g.ldb * 2;
    const size_t tstepA = 2 * hstepA, tstepB = (size_t)BM * g.ldb * 2;
    const unsigned ldsw = (unsigned)wid * 1024u;
    const int aoff = lds_byte(wr * 64 + fr, fq * 8), boff = lds_byte(wc * 32 + fr, fq * 8);
    LAS unsigned char* ldsA = lds + aoff; LAS unsigned char* ldsB = lds + 4 * HTB + boff; asm volatile("" : "+v"(ldsA), "+v"(ldsB));
#define PG8_SA(b, h) (((b) * 2 + (h)) * HTB)
#define PG8_SB(b, h) ((4 + (b) * 2 + (h)) * HTB)
#define PG8_STAGE(bufoff, gbase, voff) do { _Pragma("unroll") for (int _i = 0; _i < 2; ++_i) \
        __builtin_amdgcn_global_load_lds((const unsigned*)((const char*)(gbase) + (voff)[_i]), (LAS unsigned*)(lds + (bufoff) + ldsw + _i * 8192), 16, 0, 0); } while (0)
#define PG8_LD8(p, off) __builtin_shufflevector(*(const LAS i32x4*)((p) + (off)), *(const LAS i32x4*)((p) + (off) + 1024), 0, 1, 2, 3, 4, 5, 6, 7)
#define PG8_LDA(dst, b, h) do { _Pragma("unroll") for (int m = 0; m < 4; ++m) { if (F8) dst##8[m] = PG8_LD8(ldsA, PG8_SA(b, h) + m * 2048); else { _Pragma("unroll") for (int k = 0; k < 2; ++k) dst[m][k] = *(const LAS bf16x8*)(ldsA + PG8_SA(b, h) + m * 2048 + k * 1024); } } } while (0)
#define PG8_LDB(dst, b, h) do { _Pragma("unroll") for (int n = 0; n < 2; ++n) { if (F8) dst##8[n] = PG8_LD8(ldsB, PG8_SA(b, h) + n * 2048); else { _Pragma("unroll") for (int k = 0; k < 2; ++k) dst[n][k] = *(const LAS bf16x8*)(ldsB + PG8_SA(b, h) + n * 2048 + k * 1024); } } } while (0)
#define PG8_MMA(ai, bj, At, Bt) do { __builtin_amdgcn_s_setprio(1); _Pragma("unroll") for (int m = 0; m < 4; ++m) _Pragma("unroll") for (int n = 0; n < 2; ++n) { \
        if (F8) asm volatile("v_mfma_f32_16x16x128_f8f6f4 %0, %1, %2, %0" : "+v"(acc[ai][bj][m][n]) : "v"(Bt##8[n]), "v"(At##8[m]));   \
        else if (I8) { _Pragma("unroll") for (int k = 0; k < 2; ++k) acc[ai][bj][m][n] = __builtin_bit_cast(f32x4, __builtin_amdgcn_mfma_i32_16x16x64_i8(__builtin_bit_cast(i32x4, Bt[n][k]), __builtin_bit_cast(i32x4, At[m][k]), __builtin_bit_cast(i32x4, acc[ai][bj][m][n]), 0, 0, 0)); } \
        else { _Pragma("unroll") for (int k = 0; k < 2; ++k) acc[ai][bj][m][n] = __builtin_amdgcn_mfma_f32_16x16x32_bf16(Bt[n][k], At[m][k], acc[ai][bj][m][n], 0, 0, 0); } } __builtin_amdgcn_s_setprio(0); } while (0)
#define PG8_WAIT_V(n) asm volatile("s_waitcnt vmcnt(" #n ")" ::: "memory")
#define PG8_WAIT_L(n) asm volatile("s_waitcnt lgkmcnt(" #n ")" ::: "memory")
#define PG8_BAR __builtin_amdgcn_s_barrier()
#define PG8_SCHED __builtin_amdgcn_sched_barrier(0)
    Unit cur, nxt; int ui = 0;
    if (!S.next(0, cur)) return;
    f32x4 acc[2][2][4][2];
#pragma unroll
    for (int a = 0; a < 2; ++a)
#pragma unroll
        for (int b = 0; b < 2; ++b)
#pragma unroll
            for (int m = 0; m < 4; ++m)
#pragma unroll
                for (int n = 0; n < 2; ++n) acc[a][b][m][n] = (f32x4){0.f, 0.f, 0.f, 0.f};
    bf16x8 At[4][2], B0[2][2], B1[2][2]; i32x8 At8[4], B08[2], B18[2];
    const char* cA = (const char*)g.A + (size_t)cur.pm * tstepA; const char* cB = (const char*)g.Bt + (size_t)cur.pn * tstepB;
    PG8_STAGE(PG8_SB(0, 0), cB, voffB); PG8_STAGE(PG8_SB(0, 1), cB + hstepB, voffB); PG8_STAGE(PG8_SA(0, 0), cA, voffA); PG8_STAGE(PG8_SA(0, 1), cA + hstepA, voffA);
    if (wr == 1) PG8_BAR;
    PG8_WAIT_V(2); PG8_BAR;
    PG8_STAGE(PG8_SB(1, 0), cB + kstep, voffB); PG8_STAGE(PG8_SA(1, 0), cA + kstep, voffA); PG8_STAGE(PG8_SB(1, 1), cB + hstepB + kstep, voffB);
    PG8_WAIT_V(6); PG8_BAR;
    for (;;) {
        const bool has_next = S.next(ui + 1, nxt);
        const char* nA = has_next ? (const char*)g.A + (size_t)nxt.pm * tstepA : cA; const char* nB = has_next ? (const char*)g.Bt + (size_t)nxt.pn * tstepB : cB;
#pragma unroll 1
        for (int t = 0; t < nt; t += 2) {
            const bool last = (t == nt - 2);
            const char* a1 = cA + (size_t)(t + 1) * kstep;
            const char* a2 = last ? nA : cA + (size_t)(t + 2) * kstep; const char* b2 = last ? nB : cB + (size_t)(t + 2) * kstep;
            const char* a3 = a2 + kstep; const char* b3 = b2 + kstep;
            PG8_LDB(B0, 0, 0); PG8_LDB(B1, 0, 1); PG8_SCHED; PG8_LDA(At, 0, 0); PG8_STAGE(PG8_SA(1, 1), a1 + hstepA, voffA);
            PG8_WAIT_V(8); PG8_WAIT_L(0); PG8_BAR; PG8_MMA(0, 0, At, B0); PG8_MMA(0, 1, At, B1); PG8_BAR; PG8_SCHED;
            PG8_LDA(At, 0, 1); PG8_STAGE(PG8_SB(0, 0), b2, voffB); PG8_STAGE(PG8_SB(0, 1), b2 + hstepB, voffB); PG8_STAGE(PG8_SA(0, 0), a2, voffA);
            PG8_WAIT_V(8); PG8_WAIT_L(0); PG8_BAR; PG8_MMA(1, 0, At, B0); PG8_MMA(1, 1, At, B1); PG8_BAR; PG8_SCHED;
            PG8_LDB(B0, 1, 0); PG8_LDB(B1, 1, 1); PG8_SCHED; PG8_LDA(At, 1, 0); PG8_STAGE(PG8_SA(0, 1), a2 + hstepA, voffA);
            PG8_WAIT_V(8); PG8_WAIT_L(0); PG8_BAR; PG8_MMA(0, 0, At, B0); PG8_MMA(0, 1, At, B1); PG8_BAR; PG8_SCHED;
            PG8_LDA(At, 1, 1); PG8_STAGE(PG8_SB(1, 0), b3, voffB); PG8_STAGE(PG8_SB(1, 1), b3 + hstepB, voffB); PG8_STAGE(PG8_SA(1, 0), a3, voffA);
            PG8_WAIT_V(8); PG8_WAIT_L(0); PG8_BAR; PG8_MMA(1, 0, At, B0); PG8_MMA(1, 1, At, B1); PG8_BAR; PG8_SCHED;
        }
        if (wr == 0) PG8_BAR;
        if (F8) asm volatile("s_nop 15\n\ts_nop 7" ::: "memory");
        E(acc, cur, wr, wc, fr, fq);
        if (!has_next) break;
#pragma unroll
        for (int a = 0; a < 2; ++a)
#pragma unroll
            for (int b = 0; b < 2; ++b)
#pragma unroll
                for (int m = 0; m < 4; ++m)
#pragma unroll
                    for (int n = 0; n < 2; ++n) acc[a][b][m][n] = (f32x4){0.f, 0.f, 0.f, 0.f};
        cur = nxt; cA = nA; cB = nB; ++ui;
        if (wr == 1) PG8_BAR;
    }
    PG8_WAIT_V(0);
    PG8_BAR;
#undef PG8_SA
#undef PG8_SB
#undef PG8_STAGE
#undef PG8_LDA
#undef PG8_LDB
#undef PG8_MMA
#undef PG8_LD8
#undef PG8_WAIT_V
#undef PG8_WAIT_L
#undef PG8_BAR
#undef PG8_SCHED
}

struct EpiRowBf16 {
    static constexpr bool HEADALIGN = false;
    bf16* O; int ldc; const float* stat; const u64* statq; float inv_n; int mode;
    u64* ssqA; u64* ssqB; int a_lo, a_hi, b_lo, b_hi;
    __device__ __forceinline__ void operator()(const f32x4 (&acc)[2][2][4][2], const Unit& u, int wr, int wc, int fr, int fq) const {
        const int row0 = u.pm * BM + wr * 64 + fr, col0 = u.pn * BM + wc * 32 + 8 * fq;
#pragma unroll
        for (int ai = 0; ai < 2; ++ai)
#pragma unroll
            for (int m = 0; m < 4; ++m) {
                const int row = row0 + ai * HALF + m * 16;
                float sc; if (mode == 2) sc = 1.f; else if (mode) sc = __builtin_amdgcn_rsqf(ssq_get(statq + row) * inv_n + EPS); else sc = stat[row];
                bf16* rowp = O + (size_t)row * ldc + col0;
#pragma unroll
                for (int bj = 0; bj < 2; ++bj) {
                    const f32x4 v0 = acc[ai][bj][m][0] * sc, v1 = acc[ai][bj][m][1] * sc;
                    u32x4 w; w.x = pk2(v0[0], v0[1]); w.y = pk2(v0[2], v0[3]); w.z = pk2(v1[0], v1[1]); w.w = pk2(v1[2], v1[3]);
                    *(u32x4*)(rowp + bj * HALF) = w;
                    if (ssqA) {
                        const int hidx = u.pn * 2 + bj;
                        u64* dst = (hidx >= a_lo && hidx < a_hi) ? ssqA : ((hidx >= b_lo && hidx < b_hi) ? ssqB : nullptr);
                        if (dst) {
                            float s = v0[0] * v0[0] + v0[1] * v0[1] + v0[2] * v0[2] + v0[3] * v0[3] + v1[0] * v1[0] + v1[1] * v1[1] + v1[2] * v1[2] + v1[3] * v1[3];
                            s += __shfl_xor(s, 16); s += __shfl_xor(s, 32);
                            if (fq == 0) ssq_add(dst + row, s);
                        }
                    }
                }
            }
    }
};
struct EpiPlainBf16 {
    static constexpr bool HEADALIGN = false;
    bf16* O; int ldc;
    __device__ __forceinline__ void operator()(const f32x4 (&acc)[2][2][4][2], const Unit& u, int wr, int wc, int fr, int fq) const {
        asm volatile("" : "+v"(fr), "+v"(fq));
        bf16* base = O + (size_t)(u.pm * BM + wr * 64 + fr) * ldc + u.pn * BM + wc * 32 + 8 * fq;
#pragma unroll
        for (int ai = 0; ai < 2; ++ai)
#pragma unroll
            for (int m = 0; m < 4; ++m)
#pragma unroll
                for (int bj = 0; bj < 2; ++bj) { const f32x4 v0 = acc[ai][bj][m][0], v1 = acc[ai][bj][m][1];
                    u32x4 w; w.x = pk2(v0[0], v0[1]); w.y = pk2(v0[2], v0[3]); w.z = pk2(v1[0], v1[1]); w.w = pk2(v1[2], v1[3]);
                    *(u32x4*)(base + (size_t)(ai * HALF + m * 16) * ldc + bj * HALF) = w; }
    }
};
struct EpiResid {
    static constexpr bool HEADALIGN = false;
    bf16* xb; unsigned char* xq; u64* ssq; float mul;
    __device__ __forceinline__ void operator()(const f32x4 (&acc)[2][2][4][2], const Unit& u, int wr, int wc, int fr, int fq) const {
        const int row0 = u.pm * BM + wr * 64 + fr, col0 = u.pn * BM + wc * 32 + 8 * fq;
#pragma unroll
        for (int ai = 0; ai < 2; ++ai)
#pragma unroll
            for (int m = 0; m < 4; ++m) {
                const int row = row0 + ai * HALF + m * 16; const size_t off = (size_t)row * D + col0;
                float s = 0.f;
#pragma unroll
                for (int bj = 0; bj < 2; ++bj) {
                    const u32x4 xr = *(const u32x4*)(xb + off + bj * HALF);
                    const f32x4 x0 = {bflo(xr.x), bfhi(xr.x), bflo(xr.y), bfhi(xr.y)}, x1 = {bflo(xr.z), bfhi(xr.z), bflo(xr.w), bfhi(xr.w)};
                    const f32x4 v0 = acc[ai][bj][m][0] * mul + x0, v1 = acc[ai][bj][m][1] * mul + x1;
                    u32x4 w; w.x = pk2(v0[0], v0[1]); w.y = pk2(v0[2], v0[3]); w.z = pk2(v1[0], v1[1]); w.w = pk2(v1[2], v1[3]);
                    *(u32x4*)(xb + off + bj * HALF) = w;
                    { u32x2 w8; w8.x = pk4_i8(v0[0] * I8_XS, v0[1] * I8_XS, v0[2] * I8_XS, v0[3] * I8_XS); w8.y = pk4_i8(v1[0] * I8_XS, v1[1] * I8_XS, v1[2] * I8_XS, v1[3] * I8_XS); *(u32x2*)(xq + off + bj * HALF) = w8; }
                    s += v0[0] * v0[0] + v0[1] * v0[1] + v0[2] * v0[2] + v0[3] * v0[3] + v1[0] * v1[0] + v1[1] * v1[1] + v1[2] * v1[2] + v1[3] * v1[3];
                }
                s += __shfl_xor(s, 16); s += __shfl_xor(s, 32);
                if (fq == 0) ssq_add(ssq + row, s);
            }
    }
};
struct EpiQKVNorm {
    static constexpr bool HEADALIGN = true;
    bf16* C3; size_t cstride; const u64* ssq; const float* gq; const float* gk; float osc;
    __device__ __forceinline__ void operator()(const f32x4 (&acc)[2][2][4][2], const Unit& u, int wr, int wc, int fr, int fq) const {
        const int which = u.pn >> 2, head = (u.pn & 3) * 4 + wc;
        bf16* dst = C3 + (size_t)which * cstride;
        f32x4 gv[2][2];
#pragma unroll
        for (int bj = 0; bj < 2; ++bj)
#pragma unroll
            for (int n = 0; n < 2; ++n) { const f32x4 a = *(const f32x4*)(gq + 32 * bj + 8 * fq + 4 * n), b = *(const f32x4*)(gk + 32 * bj + 8 * fq + 4 * n);
                gv[bj][n] = which == 0 ? a : (which == 1 ? b : (f32x4){1.f, 1.f, 1.f, 1.f}); }
        const float post = which == 0 ? 0.125f * LOG2E : 1.f;
        const int row0 = u.pm * BM + wr * 64 + fr;
#pragma unroll
        for (int ai = 0; ai < 2; ++ai)
#pragma unroll
            for (int m = 0; m < 4; ++m) {
                const int row = row0 + ai * HALF + m * 16;
                const float sc = __builtin_amdgcn_rsqf(ssq_get(ssq + row) * (1.f / D) + EPS) * osc;
                f32x4 v[2][2]; float ss = 0.f;
#pragma unroll
                for (int bj = 0; bj < 2; ++bj)
#pragma unroll
                    for (int n = 0; n < 2; ++n) { v[bj][n] = acc[ai][bj][m][n] * sc; ss += v[bj][n][0] * v[bj][n][0] + v[bj][n][1] * v[bj][n][1] + v[bj][n][2] * v[bj][n][2] + v[bj][n][3] * v[bj][n][3]; }
                ss += __shfl_xor(ss, 16); ss += __shfl_xor(ss, 32);
                const float r = which == 2 ? 1.f : __builtin_amdgcn_rsqf(ss * (1.f / 64.f) + EPS) * post;
                bf16* rowp = dst + (size_t)row * 1024 + head * 64 + 8 * fq;
#pragma unroll
                for (int bj = 0; bj < 2; ++bj) { const f32x4 a = v[bj][0] * gv[bj][0] * r, b = v[bj][1] * gv[bj][1] * r;
                    u32x4 w; w.x = pk2(a[0], a[1]); w.y = pk2(a[2], a[3]); w.z = pk2(b[0], b[1]); w.w = pk2(b[2], b[3]);
                    *(u32x4*)(rowp + 32 * bj) = w; }
            }
    }
};
struct EpiProj0 {
    static constexpr bool HEADALIGN = true;
    bf16* O; const float* rstd; u64* ssq_cq; u64* ssq_ckv; u64* ssq_pe; const float* gq; const float* gk; float osc;
    __device__ __forceinline__ void operator()(const f32x4 (&acc)[2][2][4][2], const Unit& u, int wr, int wc, int fr, int fq) const {
        const int colw = u.pn * BM + wc * 64;
        const int kind = colw < 640 ? 0 : (colw < 1152 ? 1 : (colw < 1280 ? 2 : (colw < 1408 ? 3 : 4)));
        f32x4 gv[2][2];
#pragma unroll
        for (int bj = 0; bj < 2; ++bj)
#pragma unroll
            for (int n = 0; n < 2; ++n) { const f32x4 a = *(const f32x4*)(gq + 32 * bj + 8 * fq + 4 * n), b = *(const f32x4*)(gk + 32 * bj + 8 * fq + 4 * n);
                gv[bj][n] = kind == 1 ? a * (0.125f * LOG2E) : (kind == 2 ? b : (f32x4){1.f, 1.f, 1.f, 1.f}); }
        const int row0 = u.pm * BM + wr * 64 + fr;
#pragma unroll
        for (int ai = 0; ai < 2; ++ai)
#pragma unroll
            for (int m = 0; m < 4; ++m) {
                const int row = row0 + ai * HALF + m * 16;
                const float sc = rstd[row] * osc;
                f32x4 v[2][2]; float s0 = 0.f, s1 = 0.f;
#pragma unroll
                for (int n = 0; n < 2; ++n) { v[0][n] = acc[ai][0][m][n] * sc; v[1][n] = acc[ai][1][m][n] * sc;
                    s0 += v[0][n][0] * v[0][n][0] + v[0][n][1] * v[0][n][1] + v[0][n][2] * v[0][n][2] + v[0][n][3] * v[0][n][3];
                    s1 += v[1][n][0] * v[1][n][0] + v[1][n][1] * v[1][n][1] + v[1][n][2] * v[1][n][2] + v[1][n][3] * v[1][n][3]; }
                s0 += __shfl_xor(s0, 16); s0 += __shfl_xor(s0, 32); s1 += __shfl_xor(s1, 16); s1 += __shfl_xor(s1, 32);
                float r = 1.f;
                if (kind == 0) { if (fq == 0) { ssq_add((colw < 384 ? ssq_cq : ssq_ckv) + row, s0 + s1); } }
                else if (kind == 4) { if (fq == 0 && colw == 1408) ssq_add(ssq_pe + row, s0); }
                else if (kind != 3) r = __builtin_amdgcn_rsqf((s0 + s1) * (1.f / 64.f) + EPS);
                bf16* rowp = O + (size_t)row * 1536 + colw + 8 * fq;
#pragma unroll
                for (int bj = 0; bj < 2; ++bj) { const f32x4 a = v[bj][0] * gv[bj][0] * r, b = v[bj][1] * gv[bj][1] * r;
                    u32x4 w; w.x = pk2(a[0], a[1]); w.y = pk2(a[2], a[3]); w.z = pk2(b[0], b[1]); w.w = pk2(b[2], b[3]);
                    *(u32x4*)(rowp + 32 * bj) = w; }
            }
    }
};
struct EpiKVNorm {
    static constexpr bool HEADALIGN = true;
    bf16* Km; bf16* Vm; const bf16* proj; const u64* ssq_ckv; const u64* ssq_pe; const float* gk; const float* rope;
    __device__ __forceinline__ void operator()(const f32x4 (&acc)[2][2][4][2], const Unit& u, int wr, int wc, int fr, int fq) const {
        asm volatile("" : "+v"(fr), "+v"(fq));
        const int head = u.pn * 2 + (wc >> 1), part = wc & 1;
        const int row0 = u.pm * BM + wr * 64 + fr;
        float rr[8], scv[8], pev[8];
#pragma unroll
        for (int q = 0; q < 8; ++q) { const int row = row0 + (q >> 2) * HALF + (q & 3) * 16; scv[q] = ssq_get(ssq_ckv + row); pev[q] = ssq_get(ssq_pe + row); }
#pragma unroll
        for (int ai = 0; ai < 2; ++ai)
#pragma unroll
            for (int m = 0; m < 4; ++m) {
                const int row = row0 + ai * HALF + m * 16;
                const float sc = __builtin_amdgcn_rsqf(scv[ai * 4 + m] * (1.f / 256.f) + EPS);
                f32x4 v[2][2]; float ss = 0.f;
#pragma unroll
                for (int bj = 0; bj < 2; ++bj)
#pragma unroll
                    for (int n = 0; n < 2; ++n) { v[bj][n] = acc[ai][bj][m][n] * sc; ss += v[bj][n][0] * v[bj][n][0] + v[bj][n][1] * v[bj][n][1] + v[bj][n][2] * v[bj][n][2] + v[bj][n][3] * v[bj][n][3]; }
                ss += __shfl_xor(ss, 16); ss += __shfl_xor(ss, 32);
                const float r = part ? 1.f : __builtin_amdgcn_rsqf((ss + pev[ai * 4 + m]) * (1.f / 96.f) + EPS);
                rr[ai * 4 + m] = r;
                bf16* rowp = part ? Vm + (size_t)row * 512 + head * 64 + 8 * fq : Km + (size_t)row * 768 + head * 96 + 8 * fq;
#pragma unroll
                for (int bj = 0; bj < 2; ++bj) { const f32x4 ga = part ? (f32x4){1.f, 1.f, 1.f, 1.f} : *(const f32x4*)(gk + 32 * bj + 8 * fq), gb = part ? (f32x4){1.f, 1.f, 1.f, 1.f} : *(const f32x4*)(gk + 32 * bj + 8 * fq + 4);
                    const f32x4 a = v[bj][0] * ga * r, b = v[bj][1] * gb * r;
                    u32x4 w; w.x = pk2(a[0], a[1]); w.y = pk2(a[2], a[3]); w.z = pk2(b[0], b[1]); w.w = pk2(b[2], b[3]);
                    *(u32x4*)(rowp + 32 * bj) = w; }
                __builtin_amdgcn_sched_barrier(0);
            }
        if (part == 0) {
            const f32x4 g1 = *(const f32x4*)(gk + 64 + 4 * fq), g2 = *(const f32x4*)(gk + 80 + 4 * fq);
#pragma unroll
            for (int q = 0; q < 8; ++q) {
                const int row = row0 + (q >> 2) * HALF + (q & 3) * 16; const float r = rr[q];
                const u32x2 p1 = *(const u32x2*)(proj + (size_t)row * 1536 + 1408 + 4 * fq), p2 = *(const u32x2*)(proj + (size_t)row * 1536 + 1424 + 4 * fq);
                const float* cs = rope + (row & (SEQ - 1)) * 16 + 4 * fq;
                const f32x4 c = *(const f32x4*)cs, sn = *(const f32x4*)(cs + 32768);
                const f32x4 x1 = (f32x4){bflo(p1.x), bfhi(p1.x), bflo(p1.y), bfhi(p1.y)} * g1 * r, x2 = (f32x4){bflo(p2.x), bfhi(p2.x), bflo(p2.y), bfhi(p2.y)} * g2 * r;
                const f32x4 o1 = x1 * c - x2 * sn, o2 = x1 * sn + x2 * c;
                bf16* kp = Km + (size_t)row * 768 + head * 96 + 64 + 4 * fq;
                u32x2 w1, w2; w1.x = pk2(o1[0], o1[1]); w1.y = pk2(o1[2], o1[3]); w2.x = pk2(o2[0], o2[1]); w2.y = pk2(o2[2], o2[3]);
                *(u32x2*)kp = w1; *(u32x2*)(kp + 16) = w2;
            }
        }
    }
};
struct EpiScoreT {
    static constexpr bool HEADALIGN = false;
    unsigned* scT; const u64* ssq; float osc;
    __device__ __forceinline__ void operator()(const f32x4 (&acc)[2][2][4][2], const Unit& u, int wr, int wc, int fr, int fq) const {
        const int col0 = u.pn * BM + wc * 32 + 8 * fq;
#pragma unroll
        for (int ai = 0; ai < 2; ++ai) {
            const int g = u.pm * 4 + ai * 2 + wr;
#pragma unroll
            for (int m = 0; m < 4; ++m) {
                const int row = g * 64 + m * 16 + fr;
                const float sc = __builtin_amdgcn_rsqf(ssq_get(ssq + row) * (1.f / D) + EPS) * osc;
                unsigned* p = scT + ((size_t)g * 1024 + col0 / 2) * 64 + m * 16 + fr;
#pragma unroll
                for (int bj = 0; bj < 2; ++bj)
#pragma unroll
                    for (int n = 0; n < 2; ++n) { const i32x4 vi = __builtin_bit_cast(i32x4, acc[ai][bj][m][n]); const f32x4 v = {(float)vi[0] * sc, (float)vi[1] * sc, (float)vi[2] * sc, (float)vi[3] * sc};
                        p[(size_t)(bj * 64 + n * 2) * 64] = pk2(v[0], v[1]); p[(size_t)(bj * 64 + n * 2 + 1) * 64] = pk2(v[2], v[3]); }
            }
        }
    }
};
}

constexpr size_t MiB = 1u << 20;
constexpr size_t WS_CTL = 0, CTL_ZERO_BYTES = 1024 * 1024;
constexpr size_t CTL_SSQ_CQ = 128 * 1024, CTL_SSQ_CKV = 256 * 1024, CTL_SSQ_X1 = 384 * 1024, CTL_SSQ_X3 = 512 * 1024, CTL_SSQ_X2 = 640 * 1024, CTL_SSQ_PE = 768 * 1024;
constexpr int CW_BAR = 4096, CW_RANK = 8192;
constexpr size_t WS_RSTD0 = 1 * MiB, WS_RSTD2 = WS_RSTD0 + 65536, WS_ROPE = WS_RSTD2 + 65536  , WS_T5TAB = WS_ROPE + 262144  , WS_CATAB = WS_T5TAB + 8192  , WS_MQK = WS_CATAB + 20480  ;
constexpr size_t WS_W0T = 2 * MiB, WS_WUQT = 5 * MiB, WS_WUKVT = 6 * MiB, WS_WOUT0T = 7 * MiB, WS_W1T = 9 * MiB, WS_WOUT1T = 15 * MiB, WS_WPQT = 17 * MiB;
constexpr size_t WS_EIDX = 25 * MiB, WS_EW = 33 * MiB, WS_XB = 41 * MiB, WS_XA = 73 * MiB, WS_BIG = 137 * MiB, WS_ATT = 265 * MiB, WS_TAB = 361 * MiB, WS_PW = 425 * MiB, WS_MIX = 433 * MiB, WS_PKA = 465 * MiB  , WS_END = 489 * MiB;
constexpr size_t BIG_PROJ = 0, BIG_QRAW = 48 * MiB, BIG_KVRAW = 72 * MiB, BIG_MIX = 96 * MiB;
constexpr size_t ATT_QM = 0, ATT_KM = 24 * MiB, ATT_VMT = 48 * MiB, ATT_SQ = 64 * MiB, ATT_SK = 80 * MiB, ATT_SVT = 84 * MiB;
constexpr size_t ATT_CQ = 0, ATT_CK = 32 * MiB, ATT_CVT = 64 * MiB;
constexpr int RING_BYTES = 131072, MISC_OFF = RING_BYTES + 320, LDS_BYTES = 147456;

#define XB_TMO      128
#define XB_XCNT(j)  (256  + 64 * (j))
#define XB_XSUB(j)  (1280 + 64 * (j))
#define XB_XGEN(j)  (2304 + 64 * (j))
#define XB_TOP      3328
#define XB_TOPGEN   3392
#define XCD_BAR_WORDS 3456
#define XB_SPIN_CAP (1u << 18)
__device__ __forceinline__ unsigned xb_ld(unsigned* p)              { return __hip_atomic_load(p, __ATOMIC_RELAXED, __HIP_MEMORY_SCOPE_AGENT); }
__device__ __forceinline__ unsigned xb_add(unsigned* p, unsigned v) { return __hip_atomic_fetch_add(p, v, __ATOMIC_RELAXED, __HIP_MEMORY_SCOPE_AGENT); }
__device__ __forceinline__ unsigned xb_xcc_id() { return (unsigned)__builtin_amdgcn_s_getreg((3 << 11) | 20) & 0xFu; }
#define XB_SPIN(cond, bar) do { unsigned _sp = 0; while (cond) { __builtin_amdgcn_s_sleep(1); \
    if ((++_sp & 255u) == 0u) { if (xb_ld(&(bar)[XB_TMO])) break; if (_sp > XB_SPIN_CAP) { atomicAdd(&(bar)[XB_TMO], 1u); break; } } } } while (0)
struct XcdBarrier { unsigned* bar; unsigned x; volatile LAS unsigned* st; };
__device__ __forceinline__ XcdBarrier xcd_barrier_post(unsigned* bar, volatile LAS unsigned* st) {
    XcdBarrier b; b.bar = bar; b.x = xb_xcc_id(); b.st = st;
    if (threadIdx.x == 0) (void)xb_add(&bar[XB_XCNT(b.x)], 1u);
    return b;
}
__device__ __forceinline__ void xcd_barrier_complete(unsigned* bar, unsigned x, unsigned& nloc, unsigned& nx) {
    const unsigned G = gridDim.x * gridDim.y * gridDim.z;
    unsigned sum, cnt, mine, sp = 0u;
    for (;;) {
        sum = 0u; cnt = 0u; mine = 0u;
#pragma unroll
        for (unsigned j = 0; j < 16; ++j) { const unsigned c = xb_ld(&bar[XB_XCNT(j)]); sum += c; cnt += (c > 0u) ? 1u : 0u; mine = (j == x) ? c : mine; }
        if (sum == G) break;
        __builtin_amdgcn_s_sleep(1);
        if ((++sp & 255u) == 0u) { if (xb_ld(&bar[XB_TMO])) break; if (sp > XB_SPIN_CAP) { atomicAdd(&bar[XB_TMO], 1u); break; } }
    }
    nloc = mine > 0u ? mine : 1u; nx = cnt > 0u ? cnt : 1u;
}
__device__ __forceinline__ void xcd_barrier(const XcdBarrier& b) {
    asm volatile("s_waitcnt vmcnt(0)" ::: "memory");
    __syncthreads();
    if (threadIdx.x == 0) {
        unsigned* bar = b.bar;
        __builtin_amdgcn_s_waitcnt(0);
        unsigned nloc = b.st[0], nx = b.st[1];
        if (nloc == 0u) { xcd_barrier_complete(bar, b.x, nloc, nx); b.st[0] = nloc; b.st[1] = nx; }
        const unsigned old = xb_add(&bar[XB_XSUB(b.x)], 1u);
        const unsigned gen = old / nloc;
        if (old + 1u == (gen + 1u) * nloc) {
            __builtin_amdgcn_fence(__ATOMIC_RELEASE, "agent");
            asm volatile("s_waitcnt vmcnt(0)" ::: "memory");
            const unsigned og = xb_add(&bar[XB_TOP], 1u);
            const unsigned tg = og / nx;
            if (og + 1u == (tg + 1u) * nx) xb_add(&bar[XB_TOPGEN], 1u);
            else XB_SPIN(xb_ld(&bar[XB_TOPGEN]) == tg, bar);
            __builtin_amdgcn_fence(__ATOMIC_ACQUIRE, "agent");
            xb_add(&bar[XB_XGEN(b.x)], 1u);
            asm volatile("s_waitcnt vmcnt(0)" ::: "memory");
        } else {
            XB_SPIN(xb_ld(&bar[XB_XGEN(b.x)]) == gen, bar);
            __builtin_amdgcn_fence(__ATOMIC_ACQUIRE, "agent");
            asm volatile("s_waitcnt vmcnt(0)" ::: "memory");
        }
    }
    __syncthreads();
}

template <int CTRL> __device__ __forceinline__ float dpp_f(float v) { return __builtin_bit_cast(float, __builtin_amdgcn_update_dpp(0, __builtin_bit_cast(int, v), CTRL, 0xf, 0xf, true)); }
__device__ __forceinline__ float row_sum16(float v) {
    v += dpp_f<0xB1>(v); v += dpp_f<0x4E>(v); v += dpp_f<0x141>(v); v += dpp_f<0x140>(v); return v;
}
__device__ __forceinline__ float wave_sum(float v) {
    v = row_sum16(v);
    const int vi = __builtin_bit_cast(int, v);
    return __builtin_bit_cast(float, __builtin_amdgcn_readlane(vi, 0)) + __builtin_bit_cast(float, __builtin_amdgcn_readlane(vi, 16)) + __builtin_bit_cast(float, __builtin_amdgcn_readlane(vi, 32)) + __builtin_bit_cast(float, __builtin_amdgcn_readlane(vi, 48));
}
__device__ __forceinline__ float gelu_tanh(float x) {
    const float u = 0.7978845608028654f * (x + 0.044715f * x * x * x);
    return x * __builtin_amdgcn_rcpf(1.f + fexp2(-2.f * LOG2E * u));
}

__device__ __forceinline__ void p0_transpose_item(const float* W, const float* gain, int K, int N, bf16* WT, LAS float* scr, int item, int lane, bool permW0 = false, bool f8 = false) {
    const int nblk = N / 32, kb = item / nblk, nb = item % nblk, k0 = 64 * kb, n0 = 32 * nb;
    const int n0d = !permW0 ? n0 : (n0 < 640 ? n0 : (n0 < 672 ? n0 + 768 : n0 - 32));
#pragma unroll 8
    for (int i = 0; i < 32; ++i) { const int kk = 2 * i + (lane >> 5); float w = W[(size_t)(k0 + kk) * N + n0 + (lane & 31)]; if (gain) w *= gain[k0 + kk]; scr[kk * 33 + (lane & 31)] = w; }
    LDS_WAIT(); asm volatile("" ::: "memory");
    const int c = lane & 7;
#pragma unroll
    for (int j = 0; j < 4; ++j) { const int n = (lane >> 3) + 8 * j; const LAS float* s = scr + (8 * c) * 33 + n;
        u32x4 o; o.x = pk2(s[0 * 33], s[1 * 33]); o.y = pk2(s[2 * 33], s[3 * 33]); o.z = pk2(s[4 * 33], s[5 * 33]); o.w = pk2(s[6 * 33], s[7 * 33]);
        if (!f8) *(u32x4*)(WT + (size_t)(n0d + n) * K + k0 + 8 * c) = o;
        else { u32x2 o8; o8.x = pk4_fp8(s[0 * 33] * F8_WS, s[1 * 33] * F8_WS, s[2 * 33] * F8_WS, s[3 * 33] * F8_WS); o8.y = pk4_fp8(s[4 * 33] * F8_WS, s[5 * 33] * F8_WS, s[6 * 33] * F8_WS, s[7 * 33] * F8_WS);
               *(u32x2*)((unsigned char*)WT + (size_t)(n0d + n) * K + k0 + 8 * c) = o8; } }
    LDS_WAIT(); asm volatile("" ::: "memory");
}

struct Ptrs {
    const float* in[24]; float* out; unsigned char* ws;
};

__device__ __forceinline__ void p0_prologue(const Ptrs& P, LAS unsigned char* lds, int tid, int lane, int wave) {
    unsigned char* ws = P.ws;
    const int G = gridDim.x;
    const size_t gtid = (size_t)blockIdx.x * NTHR + tid, gthreads = (size_t)G * NTHR;
#pragma unroll 1
    for (int pass = 0; pass < 2; ++pass) {
      if (((blockIdx.x & 1) == 0) == (pass == 0)) {
    {
        const int gw = blockIdx.x * NWAVES + wave, NGW = G * NWAVES;
        for (int a = 0; a < 4; ++a) {
            const int l = a >> 1, isv = a & 1; const float psc = isv ? V8_SCALE : 96.f;
            const float* srcf = P.in[22 + isv] + (size_t)l * 16384 * 1024;
            unsigned char* dstb = ws + WS_TAB + (size_t)l * 32 * MiB + (size_t)isv * 16 * MiB;
            for (int e0 = gw * 4; e0 < 16384; e0 += NGW * 4) {
                f32x4 v[4][4];
#pragma unroll
                for (int r = 0; r < 4; ++r)
#pragma unroll
                    for (int q = 0; q < 4; ++q) v[r][q] = __builtin_nontemporal_load((const f32x4*)(srcf + (size_t)(e0 + r) * 1024 + q * 256) + lane);
#pragma unroll
                for (int r = 0; r < 4; ++r)
#pragma unroll
                    for (int q = 0; q < 4; ++q) { const f32x4 vv = v[r][q] * psc;
                        if (isv) { unsigned xi = 0u;
#pragma unroll
                            for (int j = 0; j < 4; ++j) xi |= ((unsigned)(int)__builtin_rintf(__builtin_amdgcn_fmed3f(vv[j], -127.f, 127.f)) & 0xffu) << (8 * j);
                            const size_t sl = 2 * q + (lane >> 5);
                            *(unsigned*)(dstb + ((sl * 16384 + (size_t)(e0 + r)) * 128 + ((4 * lane) & 127))) = (unsigned)xi; }
                        else { unsigned x = 0u;
#pragma unroll
                            for (int j = 0; j < 4; ++j) { const int qi = (int)__builtin_rintf(fminf(fmaxf(vv[j], -8.f), 7.f)); x |= ((unsigned)qi & 0xfu) << (4 * j); }
                            *(unsigned short*)(dstb + (((size_t)q * 16384 + (size_t)(e0 + r)) * 128 + 2 * lane)) = (unsigned short)x; } }
            }
        }
    }
    {
        const int gw = blockIdx.x * NWAVES + wave, NGW = G * NWAVES;
        for (int t = gw; t < T; t += NGW) {
            const f32x4* xr = (const f32x4*)(P.in[0] + (size_t)t * D) + lane;
            f32x4 v[4]; float s = 0.f;
#pragma unroll
            for (int j = 0; j < 4; ++j) { v[j] = xr[64 * j]; s += v[j][0] * v[j][0] + v[j][1] * v[j][1] + v[j][2] * v[j][2] + v[j][3] * v[j][3]; }
            s = wave_sum(s);
            u32x2* o = (u32x2*)((bf16*)(ws + WS_XB) + (size_t)t * D) + lane;
#pragma unroll
            for (int j = 0; j < 4; ++j) { u32x2 w; w.x = pk2(v[j][0], v[j][1]); w.y = pk2(v[j][2], v[j][3]); o[64 * j] = w; }
            unsigned* o8 = (unsigned*)(ws + WS_XA + 32 * MiB + (size_t)t * D) + lane;
#pragma unroll
            for (int j = 0; j < 4; ++j) o8[64 * j] = pk4_fp8(v[j][0] * F8_XS, v[j][1] * F8_XS, v[j][2] * F8_XS, v[j][3] * F8_XS);
            if (lane == 0) ((float*)(ws + WS_RSTD0))[t] = __builtin_amdgcn_rsqf(s * (1.f / D) + EPS);
        }
    }
      } else {
    {
        const int gw = blockIdx.x * NWAVES + wave, NGW = G * NWAVES;
        const int r = lane & 15, kq = lane >> 4;
        for (int it = gw; it < 2 * 16 * 16 * 8; it += NGW) {
            const int kw = it & 7, dt = (it >> 3) & 15, hp = (it >> 7) & 15, l = it >> 11;
            const float* sk = P.in[21] + ((size_t)(l * 16 + hp) * 128 + kw * 16 + r) * 128 + 8 * kq;
            const float* wq = P.in[20] + ((size_t)l * 1024 + dt * 64 + r) * 2048 + hp * 128 + 8 * kq;
            f32x4 acc[4];
#pragma unroll
            for (int m = 0; m < 4; ++m) acc[m] = (f32x4){0.f, 0.f, 0.f, 0.f};
#pragma unroll
            for (int ks = 0; ks < 4; ++ks) {
                const f32x4 b0 = *(const f32x4*)(sk + ks * 32), b1 = *(const f32x4*)(sk + ks * 32 + 4);
                u32x4 bw; bw.x = pk2(b0[0], b0[1]); bw.y = pk2(b0[2], b0[3]); bw.z = pk2(b1[0], b1[1]); bw.w = pk2(b1[2], b1[3]);
#pragma unroll
                for (int m = 0; m < 4; ++m) {
                    const f32x4 a0 = *(const f32x4*)(wq + (size_t)m * 16 * 2048 + ks * 32), a1 = *(const f32x4*)(wq + (size_t)m * 16 * 2048 + ks * 32 + 4);
                    u32x4 aw; aw.x = pk2(a0[0], a0[1]); aw.y = pk2(a0[2], a0[3]); aw.z = pk2(a1[0], a1[1]); aw.w = pk2(a1[2], a1[3]);
                    acc[m] = __builtin_amdgcn_mfma_f32_16x16x32_bf16(__builtin_bit_cast(bf16x8, aw), __builtin_bit_cast(bf16x8, bw), acc[m], 0, 0, 0);
                }
            }
            unsigned char* o = ws + WS_WPQT + ((size_t)l * 2048 + hp * 128 + kw * 16 + r) * 1024 + dt * 64 + 4 * kq;
            const float* gf = P.in[3] + l * 1024 + dt * 64 + 4 * kq;
#pragma unroll
            for (int m = 0; m < 4; ++m) { const f32x4 gv = *(const f32x4*)(gf + m * 16);
                *(unsigned*)(o + m * 16) = pk4_i8(acc[m][0] * gv[0] * I8_WS, acc[m][1] * gv[1] * I8_WS, acc[m][2] * gv[2] * I8_WS, acc[m][3] * gv[3] * I8_WS); }
        }
    }
    {
        LAS float* scr = (LAS float*)(lds + wave * 16384);
        const int gw = blockIdx.x * NWAVES + wave, NGW = G * NWAVES;
        constexpr int I0 = 16 * 45, I1 = 6 * 24, I2 = 4 * 32, I3 = 16 * 32, I4 = 16 * 96, I5 = 16 * 32;
        for (int it = gw; it < I0 + I1 + I2 + I3 + I4 + I5; it += NGW) {
            int r = it;
            if (r < I0) { p0_transpose_item(P.in[4], P.in[2], 1024, 1440, (bf16*)(ws + WS_W0T), scr, r, lane, true, true); continue; } r -= I0;
            if (r < I1) { p0_transpose_item(P.in[7], P.in[6], 384, 768, (bf16*)(ws + WS_WUQT), scr, r, lane); continue; } r -= I1;
            if (r < I2) { p0_transpose_item(P.in[9], P.in[8], 256, 1024, (bf16*)(ws + WS_WUKVT), scr, r, lane); continue; } r -= I2;
            if (r < I3) { p0_transpose_item(P.in[5], nullptr, 1024, 1024, (bf16*)(ws + WS_WOUT0T), scr, r, lane, false, true); continue; } r -= I3;
            if (r < I4) { p0_transpose_item(P.in[15], P.in[2] + 1024, 1024, 3072, (bf16*)(ws + WS_W1T), scr, r, lane, false, true); continue; } r -= I4;
            p0_transpose_item(P.in[16], nullptr, 1024, 1024, (bf16*)(ws + WS_WOUT1T), scr, r, lane, false, true);
        }
    }
    { u32x4* z = (u32x4*)(ws + WS_W0T + (size_t)1440 * 1024); for (size_t i = gtid; i < (size_t)96 * 1024 / 16; i += gthreads) z[i] = (u32x4){0u, 0u, 0u, 0u}; }
      }
    }
    for (size_t i = gtid; i < 32768; i += gthreads) {
        const int pos = (int)(i >> 4), k = (int)(i & 15);
        const float inv = powf(10000.f, -(float)(2 * k) / 32.f), ang = (float)pos * inv;
        float sn, cs; sincosf(ang, &sn, &cs);
        ((float*)(ws + WS_ROPE))[pos * 16 + k] = cs; ((float*)(ws + WS_ROPE))[32768 + pos * 16 + k] = sn;
    }
    for (size_t i = gtid; i < 8 * 256; i += gthreads) {
        const int h = (int)(i >> 8), e = (int)(i & 255), rel = e - 191;
        const int n = rel < 0 ? -rel : rel;
        int large = 8 + (int)(logf((float)(n > 1 ? n : 1) / 8.f) / logf(16.f) * 8.f + 1e-3f); if (large > 15) large = 15;
        const int bucket = (rel > 0 ? 16 : 0) + (n < 8 ? n : large);
        ((float*)(ws + WS_T5TAB))[i] = P.in[1][bucket * 8 + h] * LOG2E;
    }
    for (size_t i = gtid; i < 16 * 320; i += gthreads) ((float*)(ws + WS_CATAB))[i] = P.in[19][i] * LOG2E;
    if (blockIdx.x == 0 && wave == 0) {
        const float* gqs[3] = {P.in[10], P.in[12], P.in[17]}; const float* gks[3] = {P.in[11], P.in[13], P.in[18]};
#pragma unroll
        for (int a = 0; a < 3; ++a) {
            const int nd = a == 0 ? 96 : 64;
            float mq = 0.f, mk = 0.f;
            for (int i = lane; i < nd; i += 64) { mq = fmaxf(mq, fabsf(gqs[a][i])); mk = fmaxf(mk, fabsf(gks[a][i])); }
#pragma unroll
            for (int o = 1; o < 64; o <<= 1) { mq = fmaxf(mq, __shfl_xor(mq, o)); mk = fmaxf(mk, __shfl_xor(mk, o)); }
            if (lane == 0) ((float*)(ws + WS_MQK))[a] = (float)nd * mq * mk * (a == 0 ? 0.10206207261596577f : 0.125f) * LOG2E * 1.02f;
        }
    }
}

template <int GL, bool ROPE>
__device__ __forceinline__ void norm_core(const bf16* src, bool active, const float (&g)[8], float inv_n, float prescale, const float* cs, int j, bf16* dst) {
    u32x4 w = (u32x4){0u, 0u, 0u, 0u};
    if (active) w = *(const u32x4*)src;
    float v[8] = {bflo(w.x), bfhi(w.x), bflo(w.y), bfhi(w.y), bflo(w.z), bfhi(w.z), bflo(w.w), bfhi(w.w)};
    float ss = 0.f;
#pragma unroll
    for (int i = 0; i < 8; ++i) ss += v[i] * v[i];
    ss += dpp_f<0xB1>(ss); ss += dpp_f<0x4E>(ss); ss += dpp_f<0x141>(ss);
    if (GL == 16) ss += dpp_f<0x140>(ss);
    const float r = __builtin_amdgcn_rsqf(ss * inv_n + EPS);
#pragma unroll
    for (int i = 0; i < 8; ++i) v[i] = v[i] * r * g[i];
    if (ROPE) {
        const int ci = ((j & 1) << 3);
        const bool isx1 = (j == 8 || j == 9), isx2 = (j == 10 || j == 11);
        const f32x4 c0 = *(const f32x4*)(cs + ci), c1 = *(const f32x4*)(cs + ci + 4), s0 = *(const f32x4*)(cs + 32768 + ci), s1 = *(const f32x4*)(cs + 32768 + ci + 4);
        const float cc[8] = {c0[0], c0[1], c0[2], c0[3], c1[0], c1[1], c1[2], c1[3]}, sn[8] = {s0[0], s0[1], s0[2], s0[3], s1[0], s1[1], s1[2], s1[3]};
#pragma unroll
        for (int i = 0; i < 8; ++i) {
            const int ln = (int)(threadIdx.x & 63u);
            const float up = __shfl(v[i], (ln + 2) & 63);
            const float dn = __shfl(v[i], (ln - 2) & 63);
            const float o1 = v[i] * cc[i] - up * sn[i], o2 = dn * sn[i] + v[i] * cc[i];
            v[i] = isx1 ? o1 : (isx2 ? o2 : v[i]);
        }
    }
    if (active) { u32x4 o; o.x = pk2(v[0] * prescale, v[1] * prescale); o.y = pk2(v[2] * prescale, v[3] * prescale); o.z = pk2(v[4] * prescale, v[5] * prescale); o.w = pk2(v[6] * prescale, v[7] * prescale);
        *(u32x4*)dst = o; }
}
__device__ __forceinline__ void load_gain8(const float* gain, int j, float (&g)[8]) { const f32x4 a = *(const f32x4*)(gain + 8 * j), b = *(const f32x4*)(gain + 8 * j + 4);
    g[0] = a[0]; g[1] = a[1]; g[2] = a[2]; g[3] = a[3]; g[4] = b[0]; g[5] = b[1]; g[6] = b[2]; g[7] = b[3]; }
__device__ __forceinline__ void vt_tile(LAS unsigned char* lds, const bf16* src, int pitch, int nh, int hstride, bf16* dst, int nh_total, int hd0, int b, int s0, int tid) {
    LAS bf16* Vl = (LAS bf16*)lds; const int VP = nh * 64 + 8;
    for (int id = tid; id < 64 * nh * 8; id += NTHR) { const int tok = id / (nh * 8), rem = id % (nh * 8), hd = rem >> 3, c = rem & 7;
        *(LAS u32x4*)(Vl + tok * VP + hd * 64 + c * 8) = *(const u32x4*)(src + (size_t)tok * pitch + hd * hstride + c * 8); }
    __syncthreads();
    for (int id = tid; id < nh * 64; id += NTHR) { const int hd = id >> 6, d = id & 63;
        bf16* o = dst + ((size_t)(b * nh_total + hd0 + hd) * 64 + d) * SEQ + s0;
#pragma unroll
        for (int grp = 0; grp < 4; ++grp) {
            unsigned w[8];
#pragma unroll
            for (int pp = 0; pp < 8; ++pp) { const int p0 = 2 * pp, p1 = 2 * pp + 1;
                const int k0 = 8 * ((p0 & 7) >> 2) + 4 * (p0 >> 3) + (p0 & 3), k1 = 8 * ((p1 & 7) >> 2) + 4 * (p1 >> 3) + (p1 & 3);
                w[pp] = (unsigned)Vl[(16 * grp + k0) * VP + hd * 64 + d] | ((unsigned)Vl[(16 * grp + k1) * VP + hd * 64 + d] << 16); }
            *(u32x4*)(o + 16 * grp) = (u32x4){w[0], w[1], w[2], w[3]}; *(u32x4*)(o + 16 * grp + 8) = (u32x4){w[4], w[5], w[6], w[7]};
        }
    }
    __syncthreads();
}

__device__ __forceinline__ void prep0_phase(const Ptrs& P, LAS unsigned char* lds, int tid, int lane, int wave) {
    unsigned char* ws = P.ws;
    const bf16* proj = (const bf16*)(ws + WS_BIG + BIG_PROJ); const bf16* qraw = (const bf16*)(ws + WS_BIG + BIG_QRAW); const bf16* kvraw = (const bf16*)(ws + WS_BIG + BIG_KVRAW);
    bf16* Qm = (bf16*)(ws + WS_ATT + ATT_QM); bf16* Km = (bf16*)(ws + WS_ATT + ATT_KM);
    bf16* SQ = (bf16*)(ws + WS_ATT + ATT_SQ); bf16* SK = (bf16*)(ws + WS_ATT + ATT_SK);
    const float* rope = (const float*)(ws + WS_ROPE);
    const int j16 = lane & 15, j8 = lane & 7; const bool act16 = j16 < 12; const int jc = act16 ? j16 : 11;
    float gq[8], gk[8], gsq[8], gsk[8];
    load_gain8(P.in[10], jc, gq); load_gain8(P.in[11], jc, gk); load_gain8(P.in[12], j8, gsq); load_gain8(P.in[13], j8, gsk);
    for (int tile = blockIdx.x; tile < T / 64; tile += gridDim.x) {
#pragma unroll 1
        for (int it = 0; it < 16; ++it) {
            const int vec = it * 32 + wave * 4 + (lane >> 4), tok = vec >> 3, hd = vec & 7, t = tile * 64 + tok, pos = t & (SEQ - 1);
            const float* cs = rope + pos * 16;
            norm_core<16, true>(qraw + (size_t)t * 768 + hd * 96 + jc * 8, act16, gq, 1.f / 96.f, 0.10206207261596577f * LOG2E, cs, j16, Qm + (size_t)t * 768 + hd * 96 + jc * 8);
            const bf16* ksrc = jc < 8 ? kvraw + (size_t)t * 1024 + hd * 128 + jc * 8 : proj + (size_t)t * 1536 + 640 + (jc - 8) * 8;
            norm_core<16, true>(ksrc, act16, gk, 1.f / 96.f, 1.f, cs, j16, Km + (size_t)t * 768 + hd * 96 + jc * 8);
        }
#pragma unroll 1
        for (int it = 0; it < 8; ++it) {
            const int vec = it * 64 + wave * 8 + (lane >> 3), tok = vec >> 3, hd = vec & 7, t = tile * 64 + tok;
            norm_core<8, false>(proj + (size_t)t * 1536 + 672 + hd * 64 + j8 * 8, true, gsq, 1.f / 64.f, 0.125f * LOG2E, nullptr, j8, SQ + (size_t)t * 512 + hd * 64 + j8 * 8);
        }
#pragma unroll 1
        for (int it = 0; it < 2; ++it) {
            const int vec = it * 64 + wave * 8 + (lane >> 3), tok = vec >> 1, hd = vec & 1, t = tile * 64 + tok;
            norm_core<8, false>(proj + (size_t)t * 1536 + 1184 + hd * 64 + j8 * 8, true, gsk, 1.f / 64.f, 1.f, nullptr, j8, SK + (size_t)t * 128 + hd * 64 + j8 * 8);
        }
    }
}
__device__ __forceinline__ void prep1_phase(const Ptrs& P, LAS unsigned char* lds, int tid, int lane, int wave) {
    unsigned char* ws = P.ws;
    const bf16* qkv = (const bf16*)(ws + WS_BIG);
    bf16* CQ = (bf16*)(ws + WS_ATT + ATT_CQ); bf16* CK = (bf16*)(ws + WS_ATT + ATT_CK);
    const int j8 = lane & 7;
    float gq[8], gk[8];
    load_gain8(P.in[17], j8, gq); load_gain8(P.in[18], j8, gk);
    for (int tile = blockIdx.x; tile < T / 64; tile += gridDim.x) {
#pragma unroll 1
        for (int it = 0; it < 16; ++it) {
            const int vec = it * 64 + wave * 8 + (lane >> 3), tok = vec >> 4, hd = vec & 15, t = tile * 64 + tok;
            norm_core<8, false>(qkv + (size_t)t * 3072 + hd * 64 + j8 * 8, true, gq, 1.f / 64.f, 0.125f * LOG2E, nullptr, j8, CQ + (size_t)t * 1024 + hd * 64 + j8 * 8);
            norm_core<8, false>(qkv + (size_t)t * 3072 + 1024 + hd * 64 + j8 * 8, true, gk, 1.f / 64.f, 1.f, nullptr, j8, CK + (size_t)t * 1024 + hd * 64 + j8 * 8);
        }
    }
}

#define MFMA32(a, b, c) __builtin_amdgcn_mfma_f32_32x32x16_bf16((a), (b), (c), 0, 0, 0)
__device__ __forceinline__ constexpr int crow(int reg, int h) { return (reg & 3) + 8 * (reg >> 2) + 4 * h; }
template <int DQK, bool BIAS>
__device__ __forceinline__ void attn_tile(LAS unsigned char* Kl, LAS unsigned char* Vl, int cur, int kt, int w_lo, int w_hi, int lane, int r, int hh, const bf16x8 (&qf)[DQK / 16], f32x16& o0, f32x16& o1, float& l,
                                          float negM, const LAS float* btab, int relmin, int const_from, int qpos0, int qchunk) {
    constexpr int NK = DQK / 16, KROW = DQK * 2 + 16, KBUF = 64 * KROW, VROW = 144, VBUF = 64 * VROW;
    if (kt >= w_lo && kt <= w_hi) {
            const LAS unsigned char* Kc = Kl + cur * KBUF + r * KROW + 16 * hh;
            const LAS unsigned char* Vc = Vl + cur * VBUF + (4 * hh + ((lane & 15) >> 2)) * VROW + (16 * ((lane >> 4) & 1) + 4 * (lane & 3)) * 2;
            f32x16 s0, s1;
#pragma unroll
            for (int i = 0; i < 16; ++i) { s0[i] = negM; s1[i] = negM; }
#pragma unroll
            for (int ks = 0; ks < NK; ++ks) {
                const bf16x8 k0 = *(const LAS bf16x8*)(Kc + ks * 32), k1 = *(const LAS bf16x8*)(Kc + 32 * KROW + ks * 32);
                s0 = MFMA32(k0, qf[ks], s0); s1 = MFMA32(k1, qf[ks], s1);
            }
            if (BIAS) {
                if (qchunk - kt >= const_from) { const float c = btab[0];
#pragma unroll
                    for (int i = 0; i < 16; ++i) { s0[i] += c; s1[i] += c; }
                } else {
                    const int base = kt * 64 - (qpos0 + r) + relmin;
#pragma unroll
                    for (int i = 0; i < 16; ++i) { const int i0 = base + crow(i, 0) + 4 * hh; s0[i] += btab[i0 > 0 ? i0 : 0]; s1[i] += btab[i0 + 32 > 0 ? i0 + 32 : 0]; }
                }
            }
            float ps = 0.f;
#pragma unroll
            for (int i = 0; i < 16; ++i) { s0[i] = fexp2(s0[i]); s1[i] = fexp2(s1[i]); ps += s0[i] + s1[i]; }
            l += ps;
#pragma unroll
            for (int s2 = 0; s2 < 2; ++s2) {
                u32x4 pa, pb;
                pa.x = pk2(s0[8 * s2], s0[8 * s2 + 1]); pa.y = pk2(s0[8 * s2 + 2], s0[8 * s2 + 3]); pa.z = pk2(s0[8 * s2 + 4], s0[8 * s2 + 5]); pa.w = pk2(s0[8 * s2 + 6], s0[8 * s2 + 7]);
                pb.x = pk2(s1[8 * s2], s1[8 * s2 + 1]); pb.y = pk2(s1[8 * s2 + 2], s1[8 * s2 + 3]); pb.z = pk2(s1[8 * s2 + 4], s1[8 * s2 + 5]); pb.w = pk2(s1[8 * s2 + 6], s1[8 * s2 + 7]);
                const bf16x8 pfa = __builtin_bit_cast(bf16x8, pa), pfb = __builtin_bit_cast(bf16x8, pb);
#define TRV(keyoff, db) __builtin_shufflevector(__builtin_amdgcn_ds_read_tr16_b64_v4i16((LAS s16x4*)(Vc + (keyoff) * VROW + 64 * (db))), __builtin_amdgcn_ds_read_tr16_b64_v4i16((LAS s16x4*)(Vc + ((keyoff) + 8) * VROW + 64 * (db))), 0, 1, 2, 3, 4, 5, 6, 7)
                const bf16x8 va0 = TRV(s2 * 16, 0), va1 = TRV(s2 * 16, 1);
                const bf16x8 vb0 = TRV(32 + s2 * 16, 0), vb1 = TRV(32 + s2 * 16, 1);
#undef TRV
                o0 = MFMA32(va0, pfa, o0); o1 = MFMA32(va1, pfa, o1);
                o0 = MFMA32(vb0, pfb, o0); o1 = MFMA32(vb1, pfb, o1);
            }
        }
}
template <int DQK, bool BIAS, int QMODE>
__device__ __forceinline__ void attn_unit(LAS unsigned char* lds, int tid, int lane, const float* qgain, const float* qrope, const u64* qssq,
        const bf16* Qw, int qpitch, const bf16* Kb, int kpitch, const bf16* Vb, int vpitch,
        int t_lo, int t_hi, int w_lo, int w_hi, int qpos0, int qchunk,
        const LAS float* btab, int relmin, int const_from, float negM, float l_init, unsigned char* Ow, int opitch) {
    constexpr int NK = DQK / 16, KROW = DQK * 2 + 16, CPR = DQK / 8, KCH = 64 * CPR, KBUF = 64 * KROW, VROW = 144, VBUF = 64 * VROW;
    LAS unsigned char* Kl = lds; LAS unsigned char* Vl = lds + 2 * KBUF;
    const int r = lane & 31, hh = lane >> 5;
    bf16x8 qf[NK];
#pragma unroll
    for (int ks = 0; ks < NK; ++ks) qf[ks] = *(const bf16x8*)(Qw + (size_t)r * qpitch + ks * 16 + 8 * hh);
    if (QMODE == 1) {
        float f[NK][8]; float ss = 0.f;
#pragma unroll
        for (int ks = 0; ks < NK; ++ks) { const u32x4 w = __builtin_bit_cast(u32x4, qf[ks]);
            f[ks][0] = bflo(w.x); f[ks][1] = bfhi(w.x); f[ks][2] = bflo(w.y); f[ks][3] = bfhi(w.y); f[ks][4] = bflo(w.z); f[ks][5] = bfhi(w.z); f[ks][6] = bflo(w.w); f[ks][7] = bfhi(w.w);
#pragma unroll
            for (int j = 0; j < 8; ++j) ss += f[ks][j] * f[ks][j]; }
        ss += __shfl_xor(ss, 32);
        const float rn = __builtin_amdgcn_rsqf(ss * (1.f / DQK) + EPS * (ssq_get(qssq + r) * (1.f / 384.f) + EPS));
#pragma unroll
        for (int ks = 0; ks < NK; ++ks) { const f32x4 g0 = *(const f32x4*)(qgain + ks * 16 + 8 * hh), g1 = *(const f32x4*)(qgain + ks * 16 + 8 * hh + 4);
#pragma unroll
            for (int j = 0; j < 4; ++j) { f[ks][j] *= rn * g0[j]; f[ks][4 + j] *= rn * g1[j]; } }
        { const float* cs = qrope + (qpos0 + r) * 16 + 8 * hh;
          const f32x4 c0 = *(const f32x4*)cs, c1 = *(const f32x4*)(cs + 4), s0 = *(const f32x4*)(cs + 32768), s1 = *(const f32x4*)(cs + 32768 + 4);
#pragma unroll
          for (int j = 0; j < 8; ++j) { const float c = j < 4 ? c0[j & 3] : c1[j & 3], sn = j < 4 ? s0[j & 3] : s1[j & 3], x1 = f[4][j], x2 = f[5][j]; f[4][j] = x1 * c - x2 * sn; f[5][j] = x1 * sn + x2 * c; } }
        const float psc = 0.10206207261596577f * LOG2E;
#pragma unroll
        for (int ks = 0; ks < NK; ++ks) { u32x4 w; w.x = pk2(f[ks][0] * psc, f[ks][1] * psc); w.y = pk2(f[ks][2] * psc, f[ks][3] * psc); w.z = pk2(f[ks][4] * psc, f[ks][5] * psc); w.w = pk2(f[ks][6] * psc, f[ks][7] * psc);
            qf[ks] = __builtin_bit_cast(bf16x8, w); }
    }
    f32x16 o0, o1;
#pragma unroll
    for (int i = 0; i < 16; ++i) { o0[i] = 0.f; o1[i] = 0.f; }
    float l = hh == 0 ? l_init : 0.f;
    const int kc1 = tid + NTHR; const bool k1v = kc1 < KCH;
    const int kr0 = tid / CPR, kcc0 = tid % CPR, kr1 = kc1 / CPR, kcc1 = kc1 % CPR, vr = tid >> 3, vc = tid & 7;
    u32x4 kreg0A, kreg1A = (u32x4){0u, 0u, 0u, 0u}, vregA, kreg0B, kreg1B = (u32x4){0u, 0u, 0u, 0u}, vregB;
#define ATT_LOADS(S, kt) do { kreg0##S = *(const u32x4*)(Kb + (size_t)((kt) * 64 + kr0) * kpitch + kcc0 * 8); if (k1v) kreg1##S = *(const u32x4*)(Kb + (size_t)((kt) * 64 + kr1) * kpitch + kcc1 * 8); \
        vreg##S = *(const u32x4*)(Vb + (size_t)((kt) * 64 + vr) * vpitch + vc * 8); } while (0)
#define ATT_STORES(S, buf) do { *(LAS u32x4*)(Kl + (buf) * KBUF + kr0 * KROW + kcc0 * 16) = kreg0##S; if (k1v) *(LAS u32x4*)(Kl + (buf) * KBUF + kr1 * KROW + kcc1 * 16) = kreg1##S; \
        *(LAS u32x4*)(Vl + (buf) * VBUF + vr * VROW + vc * 16) = vreg##S; } while (0)
#define ATT_BAR() do { asm volatile("s_waitcnt lgkmcnt(0)" ::: "memory"); __builtin_amdgcn_s_barrier(); asm volatile("" ::: "memory"); } while (0)
    ATT_LOADS(A, t_lo); ATT_STORES(A, 0);
    if (t_lo + 1 <= t_hi) ATT_LOADS(B, t_lo + 1);
    ATT_BAR();
    for (int kt0 = t_lo; kt0 <= t_hi; kt0 += 2) {
        if (kt0 + 2 <= t_hi) ATT_LOADS(A, kt0 + 2);
        attn_tile<DQK, BIAS>(Kl, Vl, 0, kt0, w_lo, w_hi, lane, r, hh, qf, o0, o1, l, negM, btab, relmin, const_from, qpos0, qchunk);
        if (kt0 + 1 <= t_hi) ATT_STORES(B, 1);
        ATT_BAR();
        if (kt0 + 1 > t_hi) break;
        if (kt0 + 3 <= t_hi) ATT_LOADS(B, kt0 + 3);
        attn_tile<DQK, BIAS>(Kl, Vl, 1, kt0 + 1, w_lo, w_hi, lane, r, hh, qf, o0, o1, l, negM, btab, relmin, const_from, qpos0, qchunk);
        if (kt0 + 2 <= t_hi) ATT_STORES(A, 0);
        ATT_BAR();
    }
#undef ATT_LOADS
#undef ATT_STORES

    const float lt = l + __shfl_xor(l, 32), inv = F8_XS / lt;
    unsigned char* orow = Ow + (size_t)r * opitch + 4 * hh;
#pragma unroll
    for (int g = 0; g < 4; ++g) {
        *(unsigned*)(orow + 8 * g) = pk4_fp8(o0[4 * g] * inv, o0[4 * g + 1] * inv, o0[4 * g + 2] * inv, o0[4 * g + 3] * inv);
        *(unsigned*)(orow + 32 + 8 * g) = pk4_fp8(o1[4 * g] * inv, o1[4 * g + 1] * inv, o1[4 * g + 2] * inv, o1[4 * g + 3] * inv);
    }
}
constexpr int ATT_TAB_OFF = 2 * 64 * 208 + 2 * 64 * 144;

__device__ __forceinline__ void attn0_phase(const Ptrs& P, LAS unsigned char* lds, int tid, int lane, int wave) {
    unsigned char* ws = P.ws;
    const bf16* qraw = (const bf16*)(ws + WS_BIG + BIG_QRAW); const bf16* Km = (const bf16*)(ws + WS_ATT + ATT_KM); const bf16* Vm = (const bf16*)(ws + WS_ATT + ATT_VMT);
    const bf16* proj = (const bf16*)(ws + WS_BIG + BIG_PROJ);
    unsigned char* mix = ws + WS_MIX;
    LAS float* btab = (LAS float*)(lds + ATT_TAB_OFF) + wave * 320;
    const float Mmla = ((const float*)(ws + WS_MQK))[0], Mswa = ((const float*)(ws + WS_MQK))[1];
    for (int pi = blockIdx.x; pi < 256; pi += gridDim.x) {
        const int bh = pi & 63, qb0 = pi >> 6, b = bh >> 3, hd = bh & 7;
#pragma unroll 1
        for (int rep = 0; rep < 2; ++rep) {
            const int qb = rep ? 7 - qb0 : qb0, cw = 4 * qb + (wave >> 1), qpos0 = cw * 64 + 32 * (wave & 1);
            attn_unit<96, false, 1>(lds, tid, lane, P.in[10], (const float*)(ws + WS_ROPE), (const u64*)(ws + CTL_SSQ_CQ) + b * SEQ + qpos0, qraw + (size_t)(b * SEQ + qpos0) * 768 + hd * 96, 768, Km + (size_t)b * SEQ * 768 + hd * 96, 768, Vm + (size_t)b * SEQ * 512 + hd * 64, 512,
                0, 4 * qb + 3, 0, cw, qpos0, cw, btab, 0, 0, -Mmla, 0.f, mix + (size_t)(b * SEQ + qpos0) * 1024 + hd * 64, 1024);
        }
    }
    for (int u = blockIdx.x; u < 512; u += gridDim.x) {
        const int b = u >> 6, kvh = (u >> 5) & 1, c = u & 31, head = kvh * 4 + (wave >> 1), qpos0 = c * 64 + 32 * (wave & 1);
        const float* tab = (const float*)(ws + WS_T5TAB) + head * 256;
        float bmax = -1e30f;
#pragma unroll
        for (int i = 0; i < 4; ++i) { const float tv = tab[lane + 64 * i]; btab[lane + 64 * i] = tv; if (lane + 64 * i < 255) bmax = fmaxf(bmax, tv); }
#pragma unroll
        for (int o = 1; o < 64; o <<= 1) bmax = fmaxf(bmax, __shfl_xor(bmax, o));
        LDS_WAIT();
        const float Msw = Mswa + fmaxf(bmax, 0.f), sinkl = P.in[14][head] * LOG2E;
        const int tlo = c >= 2 ? c - 2 : 0;
        attn_unit<64, true, 0>(lds, tid, lane, nullptr, nullptr, nullptr, proj + (size_t)(b * SEQ + qpos0) * 1536 + 640 + head * 64, 1536, proj + (size_t)b * SEQ * 1536 + 1152 + kvh * 64, 1536, proj + (size_t)b * SEQ * 1536 + 1280 + kvh * 64, 1536,
            tlo, c, tlo, c, qpos0, c, btab, 191, 1000, -Msw, fexp2(sinkl - Msw), mix + (size_t)(b * SEQ + qpos0) * 1024 + 512 + head * 64, 1024);
    }
}
__device__ __forceinline__ void attn1_phase(const Ptrs& P, LAS unsigned char* lds, int tid, int lane, int wave) {
    unsigned char* ws = P.ws;
    const bf16* CQ = (const bf16*)(ws + WS_ATT + ATT_CQ); const bf16* CK = (const bf16*)(ws + WS_ATT + ATT_CK); const bf16* CV = (const bf16*)(ws + WS_ATT + ATT_CVT);
    unsigned char* mix = ws + WS_MIX;
    LAS float* btab = (LAS float*)(lds + ATT_TAB_OFF) + wave * 320;
    for (int u = blockIdx.x; u < 1024; u += gridDim.x) {
        const int qb = (u >> 7) & 7, bh = u & 127, b = bh >> 4, hd = bh & 15, cw = 4 * qb + (wave >> 1), qpos0 = cw * 64 + 32 * (wave & 1);
        const float* tab = (const float*)(ws + WS_CATAB) + hd * 320;
        float bmax = -1e30f;
#pragma unroll
        for (int i = 0; i < 5; ++i) { const float tv = tab[lane + 64 * i]; btab[lane + 64 * i] = tv; bmax = fmaxf(bmax, tv); }
#pragma unroll
        for (int o = 1; o < 64; o <<= 1) bmax = fmaxf(bmax, __shfl_xor(bmax, o));
        LDS_WAIT();
        const float Mc = ((const float*)(ws + WS_MQK))[2] + fmaxf(bmax, 0.f);
        const int tlo = 4 * qb >= 8 ? 4 * qb - 8 : 0, wlo = cw >= 8 ? cw - 8 : 0;
        attn_unit<64, true, 0>(lds, tid, lane, nullptr, nullptr, nullptr, CQ + (size_t)(b * SEQ + qpos0) * 1024 + hd * 64, 1024, CK + (size_t)b * SEQ * 1024 + hd * 64, 1024, CV + (size_t)b * SEQ * 1024 + hd * 64, 1024,
            tlo, 4 * qb + 3, wlo, cw, qpos0, cw, btab, 256, 5, -Mc, 0.f, mix + (size_t)(b * SEQ + qpos0) * 1024 + hd * 64, 1024);
    }
}

__device__ __forceinline__ int sortable(float f) { const int b = __builtin_bit_cast(int, f); return b ^ ((b >> 31) & 0x7fffffff); }
__device__ __forceinline__ float unsortable(int k) { return __builtin_bit_cast(float, k ^ ((k >> 31) & 0x7fffffff)); }
#define INS16(s, x) do { int _x = (x); _Pragma("unroll") for (int _i = 0; _i < 16; ++_i) { const int _hi = max(s[_i], _x); _x = min(s[_i], _x); s[_i] = _hi; } } while (0)
#define CE(v, a, b) { const int _h = max(v[a], v[b]); v[b] = min(v[a], v[b]); v[a] = _h; }
#define SORT16(v) do { CE(v,0,1) CE(v,2,3) CE(v,0,2) CE(v,1,3) CE(v,1,2) CE(v,4,5) CE(v,6,7) CE(v,4,6) CE(v,5,7) CE(v,5,6) CE(v,0,4) CE(v,2,6) CE(v,2,4) CE(v,1,5) CE(v,3,7) CE(v,3,5) CE(v,1,2) CE(v,3,4) CE(v,5,6) CE(v,8,9) CE(v,10,11) CE(v,8,10) CE(v,9,11) CE(v,9,10) CE(v,12,13) CE(v,14,15) CE(v,12,14) CE(v,13,15) CE(v,13,14) CE(v,8,12) CE(v,10,14) CE(v,10,12) CE(v,9,13) CE(v,11,15) CE(v,11,13) CE(v,9,10) CE(v,11,12) CE(v,13,14) CE(v,0,8) CE(v,4,12) CE(v,4,8) CE(v,2,10) CE(v,6,14) CE(v,6,10) CE(v,2,4) CE(v,6,8) CE(v,10,12) CE(v,1,9) CE(v,5,13) CE(v,5,9) CE(v,3,11) CE(v,7,15) CE(v,7,11) CE(v,3,5) CE(v,7,9) CE(v,11,13) CE(v,1,2) CE(v,3,4) CE(v,5,6) CE(v,7,8) CE(v,9,10) CE(v,11,12) CE(v,13,14) } while (0)
#define BMERGE16(v) do { CE(v,0,8) CE(v,1,9) CE(v,2,10) CE(v,3,11) CE(v,4,12) CE(v,5,13) CE(v,6,14) CE(v,7,15) CE(v,0,4) CE(v,1,5) CE(v,2,6) CE(v,3,7) CE(v,8,12) CE(v,9,13) CE(v,10,14) CE(v,11,15) CE(v,0,2) CE(v,1,3) CE(v,4,6) CE(v,5,7) CE(v,8,10) CE(v,9,11) CE(v,12,14) CE(v,13,15) CE(v,0,1) CE(v,2,3) CE(v,4,5) CE(v,6,7) CE(v,8,9) CE(v,10,11) CE(v,12,13) CE(v,14,15) } while (0)

#define MERGE_TOP16(R, S) do { _Pragma("unroll") for (int _i = 0; _i < 16; ++_i) R[_i] = max(R[_i], S[15 - _i]); BMERGE16(R); } while (0)
__device__ __forceinline__ int key_of(unsigned bits, int idx) { const int b = (int)bits; return ((b ^ ((b >> 31) & 0x7fffffff)) & ~127) | (127 - idx); }
#define TK_LOAD(dst, q) do { _Pragma("unroll") for (int _j = 0; _j < 8; ++_j) dst[_j] = (q)[(size_t)_j * 64]; } while (0)
#define TK_KEYS(K, src, k0) do { _Pragma("unroll") for (int _j = 0; _j < 8; ++_j) { K[2 * _j] = key_of(src[_j] << 16, (k0) + 2 * _j); K[2 * _j + 1] = key_of(src[_j] & 0xffff0000u, (k0) + 2 * _j + 1); } } while (0)
__device__ __forceinline__ void top16_both(const unsigned* p, int (&R1)[16], int (&R2)[16]) {
    unsigned w[8], wn[8];
    TK_LOAD(w, p);
    TK_LOAD(wn, p + (size_t)8 * 64);
    TK_KEYS(R1, w, 0); SORT16(R1);
#pragma unroll
    for (int j = 0; j < 8; ++j) w[j] = wn[j];
#pragma unroll 1
    for (int c = 1; c < 8; ++c) {
        const unsigned* q = c < 7 ? p + (size_t)(c + 1) * 8 * 64 : p + (size_t)64 * 64;
        TK_LOAD(wn, q);
        int S[16]; TK_KEYS(S, w, c * 16); SORT16(S); MERGE_TOP16(R1, S);
#pragma unroll
        for (int j = 0; j < 8; ++j) w[j] = wn[j];
    }
    const unsigned* p2 = p + (size_t)64 * 64;
    TK_LOAD(wn, p2 + (size_t)8 * 64);
    TK_KEYS(R2, w, 0); SORT16(R2);
#pragma unroll
    for (int j = 0; j < 8; ++j) w[j] = wn[j];
#pragma unroll 1
    for (int c = 1; c < 8; ++c) {
        if (c < 7) TK_LOAD(wn, p2 + (size_t)(c + 1) * 8 * 64);
        int S[16]; TK_KEYS(S, w, c * 16); SORT16(S); MERGE_TOP16(R2, S);
#pragma unroll
        for (int j = 0; j < 8; ++j) w[j] = wn[j];
    }
}
#undef TK_LOAD
#undef TK_KEYS
__device__ __forceinline__ void topk_phase(const Ptrs& P, LAS unsigned char* lds, int tid, int lane, int wave) {
    unsigned char* ws = P.ws;
    const unsigned* scT = (const unsigned*)(ws + WS_BIG);
    unsigned* poff = (unsigned*)(ws + WS_EIDX); float* pw = (float*)(ws + WS_PW);
    LAS int* idxL = (LAS int*)lds; LAS float* wL = (LAS float*)(lds + 64 * 129 * 4);
    for (int g = blockIdx.x; g < T / 64; g += gridDim.x) {
        const unsigned* base = scT + ((size_t)g * 1024 + wave * 128) * 64 + lane;
        int s1[16], s2[16];
        top16_both(base, s1, s2);
        float f1[16], f2[16];
#pragma unroll
        for (int i = 0; i < 16; ++i) { f1[i] = unsortable(s1[i] & ~127); f2[i] = unsortable(s2[i] & ~127); }
        int th[16], ga[16], gb[16];
#pragma unroll
        for (int b = 0; b < 16; ++b) th[b] = sortable(f1[0] + f2[b]);
        {
            int n = 0;
#pragma unroll
            for (int a = 1; a < 16; ++a)
#pragma unroll
                for (int b = 0; b < 16 / (a + 1); ++b) { const int x = sortable(f1[a] + f2[b]); if (n < 16) ga[n] = x; else if (n < 32) gb[n - 16] = x; ++n; }
        }
        SORT16(ga); MERGE_TOP16(th, ga); SORT16(gb); MERGE_TOP16(th, gb);
        { const int x14 = sortable(f1[14] + f2[0]), x15 = sortable(f1[15] + f2[0]); INS16(th, x14); INS16(th, x15); }
        const int tau = th[15]; const float cmax = f1[0] + f2[0];
        int cnt = 0; float sum = 0.f; int ngt = 0;
        const int rowo = lane * 129 + wave * 16;
#pragma unroll
        for (int a = 0; a < 16; ++a)
#pragma unroll
            for (int b = 0; b < 16 / (a + 1); ++b) ngt += sortable(f1[a] + f2[b]) > tau ? 1 : 0;
        int eq_left = 16 - ngt;
#pragma unroll
        for (int a = 0; a < 16; ++a)
#pragma unroll
            for (int b = 0; b < 16 / (a + 1); ++b) {
                const float c = f1[a] + f2[b]; const int xs = sortable(c);
                const bool iseq = xs == tau;
                if (xs > tau || (iseq && eq_left > 0)) {
                    eq_left -= iseq ? 1 : 0;
                    const float w = fexp2((c - cmax) * LOG2E); sum += w;
                    idxL[rowo + cnt] = ((127 - (s1[a] & 127)) << 7) | (127 - (s2[b] & 127)); wL[rowo + cnt] = w; ++cnt;
                }
            }
        const float inv = 1.f / sum;
#pragma unroll
        for (int i = 0; i < 16; ++i) wL[rowo + i] *= inv;
        __syncthreads();
#pragma unroll
        for (int i = 0; i < 16; ++i) { const int flat = i * NTHR + tid, tok = flat >> 7, k = flat & 127;
            poff[(size_t)(g * 64 + tok) * 128 + k] = (unsigned)idxL[tok * 129 + k] << 7; pw[(size_t)(g * 64 + tok) * 128 + k] = wL[tok * 129 + k]; }
        __syncthreads();
    }
}

struct XcdPart { int wr, nw, s0, ns; };
#define G8_LOADS(ur, base, oL, bufo, blk) do { _Pragma("unroll") for (int _q = 0; _q < 2; ++_q) { const u32x4 _o = *(const LAS u32x4*)((oL) + (bufo) + g * 128 + (blk) * 8 + 4 * _q); \
        _Pragma("unroll") for (int _j = 0; _j < 4; ++_j) ur[4 * _q + _j] = *(const u32x4*)((base) + (size_t)(_o[_j] | c16)); } } while (0)
#define G8_SCHED() __builtin_amdgcn_sched_barrier(0)
__device__ __forceinline__ int dpp_i(int v, int) { return v; }
template <int CTRL> __device__ __forceinline__ int dpp_iadd(int v) { return v + __builtin_amdgcn_update_dpp(0, v, CTRL, 0xf, 0xf, true); }
__device__ __forceinline__ void gatherU_phase(LAS unsigned char* lds, const bf16* xin, const u64* ssq, const float* gffn, const unsigned char* Us, const unsigned* poff, float* part, const XcdPart& X, int lane, int wave) {
    const int g = lane >> 3, c = lane & 7, nw = X.nw; const unsigned c16 = (unsigned)c * 16u;
    LAS int* rL = (LAS int*)(lds + wave * 16384);
    LAS float* sL = (LAS float*)(lds + wave * 16384 + 4096);
    LAS unsigned* oL = (LAS unsigned*)(lds + wave * 16384 + 8192);
    for (int sl = X.s0; sl < 8; sl += X.ns) {
        const int s4 = sl & 3, gend = ((sl >> 2) + 1) * (T / 16);
        const float* gfs = gffn + 256 * s4 + 32 * c;
        const unsigned char* Ub = Us + (size_t)s4 * 16384 * 128;
        int grp = (sl >> 2) * (T / 16) + X.wr; if (grp >= gend) continue;
        u32x4 oq[4], xpre[4]; u64 spre = 0; int gnext = 0; u32x4 urA[8], urB[8]; int hqh[4], hql[4]; float deq = 0.f, deqn = 0.f;
#define GU_LOADA(gg) do { _Pragma("unroll") for (int _q = 0; _q < 4; ++_q) { oq[_q] = *(const u32x4*)(poff + (size_t)(gg) * 1024 + 16 * lane + 4 * _q); \
            xpre[_q] = *(const u32x4*)(xin + (size_t)((gg) * 8 + g) * D + 256 * s4 + 32 * c + 8 * _q); } spre = ssq[(gg) * 8 + g]; gnext = (gg); } while (0)
#define GU_WRITEA(bufo) do { _Pragma("unroll") for (int _q = 0; _q < 4; ++_q) *(LAS u32x4*)(oL + (bufo) + 16 * lane + 4 * _q) = oq[_q]; \
            const float _rs = __builtin_amdgcn_rsqf((float)spre * 2.3283064365386963e-10f * (1.f / D) + EPS); \
            float _h[32]; float _mx = 1e-20f; \
            _Pragma("unroll") for (int _q = 0; _q < 4; ++_q) { const f32x4 _g0 = *(const f32x4*)(gfs + 8 * _q), _g1 = *(const f32x4*)(gfs + 8 * _q + 4); const u32x4 _xw = xpre[_q]; \
                _Pragma("unroll") for (int _j = 0; _j < 4; ++_j) { const float _ga = _j < 2 ? _g0[2 * (_j & 1)] : _g1[2 * (_j & 1)], _gb = _j < 2 ? _g0[2 * (_j & 1) + 1] : _g1[2 * (_j & 1) + 1]; \
                    _h[8 * _q + 2 * _j] = bflo(_xw[_j]) * _rs * _ga; _h[8 * _q + 2 * _j + 1] = bfhi(_xw[_j]) * _rs * _gb; _mx = fmaxf(_mx, fmaxf(fabsf(_h[8 * _q + 2 * _j]), fabsf(_h[8 * _q + 2 * _j + 1]))); } } \
            _mx = fmaxf(_mx, dpp_f<0xB1>(_mx)); _mx = fmaxf(_mx, dpp_f<0x4E>(_mx)); _mx = fmaxf(_mx, dpp_f<0x141>(_mx)); \
            const float _sh = 112.f * __builtin_amdgcn_rcpf(_mx); deqn = _mx * (1.f / (112.f * 96.f)); \
            _Pragma("unroll") for (int _q = 0; _q < 4; ++_q) { unsigned _wh = 0u, _wl = 0u; _Pragma("unroll") for (int _j = 0; _j < 8; ++_j) { const int _qi = (int)__builtin_rintf(_h[8 * _q + _j] * _sh); \
                const int _lo = ((_qi + 8) & 15) - 8, _hi = (_qi - _lo) >> 4; _wh |= ((unsigned)_hi & 0xfu) << (4 * _j); _wl |= ((unsigned)_lo & 0xfu) << (4 * _j); } hqh[_q] = (int)_wh; hql[_q] = (int)_wl; } } while (0)
#define GU_COMPUTE(ur, blk) do { int _r = 0; _Pragma("unroll") for (int _i = 0; _i < 8; ++_i) { int _dh = 0, _dl = 0; \
            _Pragma("unroll") for (int _j = 0; _j < 4; ++_j) { _dh = __builtin_amdgcn_sdot8((int)ur[_i][_j], hqh[_j], _dh, false); _dl = __builtin_amdgcn_sdot8((int)ur[_i][_j], hql[_j], _dl, false); } \
            int _d = 16 * _dh + _dl; _d = dpp_iadd<0xB1>(_d); _d = dpp_iadd<0x4E>(_d); _d = dpp_iadd<0x141>(_d); \
            _r = (c == _i) ? _d : _r; } rL[g * 128 + 8 * (blk) + c] = _r; } while (0)
        GU_LOADA(grp); GU_WRITEA(0); deq = deqn;
        int bufo = 0;
        G8_LOADS(urA, Ub, oL, bufo, 0);
        for (;;) {
            const int nxt = grp + nw; const bool has = nxt < gend;
            if (has) GU_LOADA(nxt);
            if (c == 0) sL[g] = deq;
#pragma unroll 1
            for (int bp = 0; bp < 8; ++bp) {
                G8_LOADS(urB, Ub, oL, bufo, 2 * bp + 1); G8_SCHED();
                GU_COMPUTE(urA, 2 * bp); G8_SCHED();
                if (bp < 7) { G8_LOADS(urA, Ub, oL, bufo, 2 * bp + 2); G8_SCHED(); GU_COMPUTE(urB, 2 * bp + 1); }
                else {
                    GU_COMPUTE(urB, 2 * bp + 1); G8_SCHED();
                    if (has) { GU_WRITEA(bufo ^ 1024); G8_LOADS(urA, Ub, oL, bufo ^ 1024, 0); }
                }
                G8_SCHED();
            }
            G8_SCHED();
#pragma unroll 4
            for (int q = 0; q < 16; ++q) part[(size_t)s4 * T * 128 + (size_t)grp * 1024 + q * 64 + lane] = (float)rL[q * 64 + lane] * sL[q >> 1];
            G8_SCHED();
            if (!has) break;
            grp = nxt; bufo ^= 1024; deq = deqn;
        }
#undef GU_LOADA
#undef GU_WRITEA
#undef GU_COMPUTE
    }
}
__device__ __forceinline__ void gatherPack_phase(const unsigned* poff, const float* pw, const float* part, unsigned* pka, float* asc, int tid, float mul) {
    const size_t gt = (size_t)blockIdx.x * NTHR + tid, gth = (size_t)gridDim.x * NTHR;
    for (size_t i = gt; i < (size_t)T * 128 / 4; i += gth) {
        const u32x4 po = ((const u32x4*)poff)[i]; const f32x4 wv = ((const f32x4*)pw)[i];
        const f32x4 dq = (((const f32x4*)part)[i] + ((const f32x4*)part)[i + (size_t)T * 32]) + (((const f32x4*)part)[i + (size_t)T * 64] + ((const f32x4*)part)[i + (size_t)T * 96]);
        f32x4 av; float mx = 0.f;
#pragma unroll
        for (int j = 0; j < 4; ++j) { av[j] = gelu_tanh(dq[j]) * wv[j] * mul; mx = fmaxf(mx, fabsf(av[j])); }
        mx = fmaxf(mx, dpp_f<0xB1>(mx)); mx = fmaxf(mx, dpp_f<0x4E>(mx)); mx = fmaxf(mx, dpp_f<0x141>(mx)); mx = fmaxf(mx, dpp_f<0x140>(mx)); mx = fmaxf(mx, __shfl_xor(mx, 16));
        mx = fmaxf(mx, 1e-30f);
        const float qs = 127.f * __builtin_amdgcn_rcpf(mx);
        u32x4 o;
#pragma unroll
        for (int j = 0; j < 4; ++j) o[j] = ((po[j] >> 7) << 16) | ((unsigned)(int)__builtin_rintf(av[j] * qs) & 0xffu);
        ((u32x4*)pka)[i] = o;
        if ((i & 31) == 0) asc[i >> 5] = mx * (1.f / (127.f * V8_SCALE));
    }
}
__device__ __forceinline__ void gatherV_phase(LAS unsigned char* lds, const bf16* xin, const unsigned char* Vs, const unsigned* pka, const float* asc, float* xout, bf16* xbout, unsigned char* xqout, u64* ssq_out,
                                              const XcdPart& X, int lane, int wave) {
    const int g = lane >> 3, c = lane & 7, nw = X.nw; const unsigned c16 = (unsigned)c * 16u;
    LAS unsigned* aL = (LAS unsigned*)(lds + wave * 16384);
    LAS unsigned* oL = (LAS unsigned*)(lds + wave * 16384 + 8192);
    for (int sl = X.s0; sl < 8; sl += X.ns) {
        const unsigned char* Vb = Vs + (size_t)sl * 16384 * 128;
        int grp = X.wr; if (grp >= T / 8) continue;
        u32x4 oq[4]; u32x4 urA[8], urB[8]; int acc[16];
#define GV_LOADA(gg) do { _Pragma("unroll") for (int _q = 0; _q < 4; ++_q) oq[_q] = *(const u32x4*)(pka + (size_t)(gg) * 1024 + 16 * lane + 4 * _q); } while (0)
#define GV_WRITEA(bufo) do { _Pragma("unroll") for (int _q = 0; _q < 4; ++_q) { u32x4 _o; \
            _Pragma("unroll") for (int _j = 0; _j < 4; ++_j) _o[_j] = (oq[_q][_j] >> 16) << 7; \
            *(LAS u32x4*)(oL + (bufo) + 16 * lane + 4 * _q) = _o; \
            aL[((bufo) >> 2) + 4 * lane + _q] = (oq[_q][0] & 0xffu) | ((oq[_q][1] & 0xffu) << 8) | ((oq[_q][2] & 0xffu) << 16) | (oq[_q][3] << 24); } } while (0)
#define GV_COMPUTE(ur, blk) do { const u32x2 _aw = *(const LAS u32x2*)(aL + (bufo >> 2) + g * 32 + 2 * (blk)); \
            _Pragma("unroll") for (int _h = 0; _h < 2; ++_h) { const int _a4 = (int)_aw[_h]; \
                _Pragma("unroll") for (int _j = 0; _j < 4; ++_j) { const unsigned _r0 = ur[4 * _h][_j], _r1 = ur[4 * _h + 1][_j], _r2 = ur[4 * _h + 2][_j], _r3 = ur[4 * _h + 3][_j]; \
                    const unsigned _t0 = __builtin_amdgcn_perm(_r1, _r0, 0x05010400u), _t1 = __builtin_amdgcn_perm(_r1, _r0, 0x07030602u), _u0 = __builtin_amdgcn_perm(_r3, _r2, 0x05010400u), _u1 = __builtin_amdgcn_perm(_r3, _r2, 0x07030602u); \
                    acc[4 * _j] = __builtin_amdgcn_sdot4((int)__builtin_amdgcn_perm(_u0, _t0, 0x05040100u), _a4, acc[4 * _j], false); acc[4 * _j + 1] = __builtin_amdgcn_sdot4((int)__builtin_amdgcn_perm(_u0, _t0, 0x07060302u), _a4, acc[4 * _j + 1], false); \
                    acc[4 * _j + 2] = __builtin_amdgcn_sdot4((int)__builtin_amdgcn_perm(_u1, _t1, 0x05040100u), _a4, acc[4 * _j + 2], false); acc[4 * _j + 3] = __builtin_amdgcn_sdot4((int)__builtin_amdgcn_perm(_u1, _t1, 0x07060302u), _a4, acc[4 * _j + 3], false); } } } while (0)
        GV_LOADA(grp); GV_WRITEA(0);
        int bufo = 0;
        G8_LOADS(urA, Vb, oL, bufo, 0);
        for (;;) {
            const int nxt = grp + nw; const bool has = nxt < T / 8;
            if (has) GV_LOADA(nxt);
            const size_t xoff = (size_t)(grp * 8 + g) * D + 128 * sl + 16 * c;
            const float dsc = asc[grp * 8 + g];
            const u32x4 xw0 = *(const u32x4*)(xin + xoff), xw1 = *(const u32x4*)(xin + xoff + 8);
#pragma unroll
            for (int i = 0; i < 16; ++i) acc[i] = 0;
#pragma unroll 1
            for (int bp = 0; bp < 8; ++bp) {
                G8_LOADS(urB, Vb, oL, bufo, 2 * bp + 1); G8_SCHED();
                GV_COMPUTE(urA, 2 * bp); G8_SCHED();
                if (bp < 7) G8_LOADS(urA, Vb, oL, bufo, 2 * bp + 2);
                else if (has) { GV_WRITEA(bufo ^ 1024); G8_LOADS(urA, Vb, oL, bufo ^ 1024, 0); }
                G8_SCHED();
                GV_COMPUTE(urB, 2 * bp + 1); G8_SCHED();
            }
            float ss = 0.f;
            u32x4 ob0, ob1, oq8;
#pragma unroll
            for (int q = 0; q < 4; ++q) {
                const unsigned wa = q < 2 ? xw0[2 * (q & 1)] : xw1[2 * (q & 1)], wb = q < 2 ? xw0[2 * (q & 1) + 1] : xw1[2 * (q & 1) + 1];
                f32x4 y; y[0] = bflo(wa) + (float)acc[4 * q] * dsc; y[1] = bfhi(wa) + (float)acc[4 * q + 1] * dsc; y[2] = bflo(wb) + (float)acc[4 * q + 2] * dsc; y[3] = bfhi(wb) + (float)acc[4 * q + 3] * dsc;
                ss += y[0] * y[0] + y[1] * y[1] + y[2] * y[2] + y[3] * y[3];
                if (xout) *(f32x4*)(xout + xoff + 4 * q) = y;
                oq8[q] = pk4_fp8(y[0] * F8_XS, y[1] * F8_XS, y[2] * F8_XS, y[3] * F8_XS);
                if (q < 2) { ob0[2 * (q & 1)] = pk2(y[0], y[1]); ob0[2 * (q & 1) + 1] = pk2(y[2], y[3]); } else { ob1[2 * (q & 1)] = pk2(y[0], y[1]); ob1[2 * (q & 1) + 1] = pk2(y[2], y[3]); }
            }
            if (xbout) { *(u32x4*)(xbout + xoff) = ob0; *(u32x4*)(xbout + xoff + 8) = ob1; }
            if (xqout) *(u32x4*)(xqout + xoff) = oq8;
            if (ssq_out) { ss += dpp_f<0xB1>(ss); ss += dpp_f<0x4E>(ss); ss += dpp_f<0x141>(ss); if (c == 0) ssq_add(ssq_out + grp * 8 + g, ss); }
            if (!has) break;
            grp = nxt; bufo ^= 1024;
        }
#undef GV_LOADA
#undef GV_WRITEA
#undef GV_COMPUTE
    }
}

#ifndef DBG_NOMIX
#define DBG_NOMIX 0
#endif
#ifndef DBG_NOPEER
#define DBG_NOPEER 0
#endif
struct Args { Ptrs p; int ph_lo, ph_hi; };
constexpr int NPHASE = 18;

__global__ void __launch_bounds__(NTHR, 2) mega_fwd(Args args) {
    extern __shared__ __attribute__((aligned(16))) unsigned char lds_raw[];
    LAS unsigned char* lds = (LAS unsigned char*)lds_raw;
    const Ptrs& P = args.p;
    unsigned char* ws = P.ws;
    const int tid = threadIdx.x, lane = tid & 63, wave = __builtin_amdgcn_readfirstlane(tid >> 6);
    volatile LAS unsigned* MISC = (volatile LAS unsigned*)(lds + MISC_OFF);
    if (tid < 32) MISC[tid] = 0u;
    __syncthreads();
    const int lo = args.ph_lo, hi = args.ph_hi;
    const bool multi = (hi - lo) > 1;
    XcdBarrier bar; bar.bar = (unsigned*)(ws + WS_CTL) + CW_BAR; bar.x = 0; bar.st = nullptr;
    if (multi) bar = xcd_barrier_post((unsigned*)(ws + WS_CTL) + CW_BAR, MISC + 8);
#ifndef PH_MASK
#define PH_MASK 0x3ffff
#endif
#define IN(k) ((((PH_MASK) >> (k)) & 1) && lo <= (k) && (k) < hi)
#define SEAM(k) do { if (IN(k) && IN((k) + 1)) xcd_barrier(bar); } while (0)
    const int G = gridDim.x, cid = blockIdx.x;
    const unsigned xcc = xb_xcc_id();
    if (tid == 0) MISC[16] = xb_add((unsigned*)(ws + WS_CTL) + CW_RANK + 64 * xcc, 1u);
    __syncthreads();
#define XCD_PART() XcdPart X; { unsigned nloc = 1, ord = 0, nx = 0; _Pragma("unroll") for (unsigned j = 0; j < 16; ++j) { const unsigned cj = xb_ld((unsigned*)(ws + WS_CTL) + CW_RANK + 64 * j); \
        nx += cj > 0u; ord += (cj > 0u && j < xcc); nloc = (j == xcc) ? cj : nloc; } \
        X.wr = (int)(MISC[16] * NWAVES) + wave; X.nw = (int)(nloc * NWAVES); X.s0 = (int)ord; X.ns = (int)(nx ? nx : 1u); }
    u64* ssq_cq = (u64*)(ws + CTL_SSQ_CQ); u64* ssq_ckv = (u64*)(ws + CTL_SSQ_CKV); u64* ssq_x1 = (u64*)(ws + CTL_SSQ_X1); u64* ssq_x3 = (u64*)(ws + CTL_SSQ_X3); u64* ssq_x2 = (u64*)(ws + CTL_SSQ_X2); u64* ssq_pe = (u64*)(ws + CTL_SSQ_PE);
    bf16* xb = (bf16*)(ws + WS_XB);
    bf16* big = (bf16*)(ws + WS_BIG);

    if (IN(0)) { p0_prologue(P, lds, tid, lane, wave); }
    SEAM(0);
    if (IN(1)) {
        pg8::Gemm g{(const bf16*)(ws + WS_XA + 32 * MiB), (const bf16*)(ws + WS_W0T), T, 1536, 512, 512, 512}; pg8::StaticOrder S; S.init(T, 1536, G, cid);
        pg8::EpiProj0 E{big, (const float*)(ws + WS_RSTD0), ssq_cq, ssq_ckv, ssq_pe, P.in[12], P.in[13], 1.f / (F8_XS * F8_WS)};
        pg8::gemm_phase<pg8::EpiProj0, true>(lds, g, S, E);
    }
    SEAM(1);
    if (IN(2)) {
        { pg8::Gemm g{big, (const bf16*)(ws + WS_WUQT), T, 768, 384, 1536, 384}; pg8::StaticOrder S; S.init(T, 768, G, cid);
          pg8::EpiPlainBf16 E{(bf16*)(ws + WS_BIG + BIG_QRAW), 768};
          pg8::gemm_phase(lds, g, S, E); }
        { pg8::Gemm g{big + 384, (const bf16*)(ws + WS_WUKVT), T, 1024, 256, 1536, 256}; pg8::StaticOrder S; S.init(T, 1024, G, cid);
          pg8::EpiKVNorm E{(bf16*)(ws + WS_ATT + ATT_KM), (bf16*)(ws + WS_ATT + ATT_VMT), big, ssq_ckv, ssq_pe, P.in[11], (const float*)(ws + WS_ROPE)};
          pg8::gemm_phase(lds, g, S, E); }
    }
    SEAM(2);
    if (IN(3)) { attn0_phase(P, lds, tid, lane, wave); }
    SEAM(3);
    if (IN(4)) {
        pg8::Gemm g{(const bf16*)(ws + WS_MIX), (const bf16*)(ws + WS_WOUT0T), T, 1024, 512, 512, 512}; pg8::StaticOrder S; S.init(T, 1024, G, cid);
        pg8::EpiResid E{xb, ws + WS_XA + 32 * MiB, ssq_x1, (DBG_NOMIX & 1) ? 0.f : 1.f / (F8_XS * F8_WS)};
        pg8::gemm_phase<pg8::EpiResid, true>(lds, g, S, E);
    }
    SEAM(4);
    if (IN(5)) {
        pg8::Gemm g{(const bf16*)(ws + WS_XA + 32 * MiB), (const bf16*)(ws + WS_WPQT), T, 2048, 512, 512, 512}; pg8::StaticOrder S; S.init(T, 2048, G, cid);
        pg8::EpiScoreT E{(unsigned*)(ws + WS_BIG), ssq_x1, 1.f / (I8_XS * I8_WS)};
        pg8::gemm_phase<pg8::EpiScoreT, false, true>(lds, g, S, E);
    }
    SEAM(5);
    if (IN(6)) { topk_phase(P, lds, tid, lane, wave); }
    SEAM(6);
    if (IN(7)) {
        XCD_PART();
        gatherU_phase(lds, xb, ssq_x1, P.in[3], ws + WS_TAB, (const unsigned*)(ws + WS_EIDX), (float*)(ws + WS_XA), X, lane, wave);
    }
    SEAM(7);
    if (IN(8)) { gatherPack_phase((const unsigned*)(ws + WS_EIDX), (const float*)(ws + WS_PW), (const float*)(ws + WS_XA), (unsigned*)(ws + WS_PKA), (float*)(ws + WS_EW), tid, (DBG_NOPEER & 1) ? 0.f : 1.f); }
    SEAM(8);
    if (IN(9)) {
        XCD_PART();
        gatherV_phase(lds, xb, ws + WS_TAB + 16 * MiB, (const unsigned*)(ws + WS_PKA), (const float*)(ws + WS_EW), nullptr, xb, ws + WS_XA + 32 * MiB, ssq_x2, X, lane, wave);
    }
    SEAM(9);
    if (IN(10)) {
        pg8::Gemm g{(const bf16*)(ws + WS_XA + 32 * MiB), (const bf16*)(ws + WS_W1T), T, 3072, 512, 512, 512}; pg8::StaticOrder S; S.init(T, 3072, G, cid);
        pg8::EpiQKVNorm E{(bf16*)(ws + WS_ATT + ATT_CQ), (size_t)(32 * MiB / 2), ssq_x2, P.in[17], P.in[18], 1.f / (F8_XS * F8_WS)};
        pg8::gemm_phase<pg8::EpiQKVNorm, true>(lds, g, S, E);
    }
    SEAM(10);
    if (IN(11)) { attn1_phase(P, lds, tid, lane, wave); }
    SEAM(11);
    if (IN(12)) {
        pg8::Gemm g{(const bf16*)(ws + WS_MIX), (const bf16*)(ws + WS_WOUT1T), T, 1024, 512, 512, 512}; pg8::StaticOrder S; S.init(T, 1024, G, cid);
        pg8::EpiResid E{xb, ws + WS_XA + 32 * MiB, ssq_x3, (DBG_NOMIX & 2) ? 0.f : 1.f / (F8_XS * F8_WS)};
        pg8::gemm_phase<pg8::EpiResid, true>(lds, g, S, E);
    }
    SEAM(12);
    if (IN(13)) {
        pg8::Gemm g{(const bf16*)(ws + WS_XA + 32 * MiB), (const bf16*)(ws + WS_WPQT + (size_t)2048 * 1024), T, 2048, 512, 512, 512}; pg8::StaticOrder S; S.init(T, 2048, G, cid);
        pg8::EpiScoreT E{(unsigned*)(ws + WS_BIG), ssq_x3, 1.f / (I8_XS * I8_WS)};
        pg8::gemm_phase<pg8::EpiScoreT, false, true>(lds, g, S, E);
    }
    SEAM(13);
    if (IN(14)) { topk_phase(P, lds, tid, lane, wave); }
    SEAM(14);
    if (IN(15)) {
        XCD_PART();
        gatherU_phase(lds, xb, ssq_x3, P.in[3] + 1024, ws + WS_TAB + 32 * MiB, (const unsigned*)(ws + WS_EIDX), (float*)(ws + WS_XA), X, lane, wave);
    }
    SEAM(15);
    if (IN(16)) { gatherPack_phase((const unsigned*)(ws + WS_EIDX), (const float*)(ws + WS_PW), (const float*)(ws + WS_XA), (unsigned*)(ws + WS_PKA), (float*)(ws + WS_EW), tid, (DBG_NOPEER & 2) ? 0.f : 1.f); }
    SEAM(16);
    if (IN(17)) {
        XCD_PART();
        gatherV_phase(lds, xb, ws + WS_TAB + 48 * MiB, (const unsigned*)(ws + WS_PKA), (const float*)(ws + WS_EW), P.out, nullptr, nullptr, nullptr, X, lane, wave);
    }
#undef IN
#undef SEAM
}

#ifndef MK_ONE_LAUNCH
#define MK_ONE_LAUNCH 1
#endif

extern "C" void kernel_launch(void* const* d_in, const int* in_sizes, int n_in, void* d_out, int out_size, void* d_ws, size_t ws_size, hipStream_t stream) {
    static int grid = 0;
    if (grid == 0) {
        if (n_in != 24 || in_sizes[0] != T * D || out_size != T * D || ws_size < WS_END) { fprintf(stderr, "kernel_launch: unexpected shapes (n_in %d, ws %zu)\n", n_in, ws_size); grid = -1; return; }
        int dev = 0, cus = 0, per_cu = 0;
        if (hipGetDevice(&dev) != hipSuccess || hipDeviceGetAttribute(&cus, hipDeviceAttributeMultiprocessorCount, dev) != hipSuccess) { grid = -1; return; }
        if (hipFuncSetAttribute((const void*)mega_fwd, hipFuncAttributeMaxDynamicSharedMemorySize, LDS_BYTES) != hipSuccess) { fprintf(stderr, "kernel_launch: hipFuncSetAttribute failed\n"); grid = -1; return; }
        if (hipOccupancyMaxActiveBlocksPerMultiprocessor(&per_cu, (const void*)mega_fwd, NTHR, LDS_BYTES) != hipSuccess || per_cu < 1) { fprintf(stderr, "kernel_launch: occupancy query says %d blocks per CU\n", per_cu); }
        (void)hipGetLastError();
        grid = cus;
    }
    if (grid < 0) return;
    if (hipMemsetAsync((char*)d_ws + WS_CTL, 0, CTL_ZERO_BYTES, stream) != hipSuccess) return;
    Args a{};
    for (int i = 0; i < 24; ++i) a.p.in[i] = (const float*)d_in[i];
    a.p.out = (float*)d_out; a.p.ws = (unsigned char*)d_ws;
#if MK_ONE_LAUNCH
    a.ph_lo = 0; a.ph_hi = NPHASE;
    hipLaunchKernelGGL(mega_fwd, dim3(grid), dim3(NTHR), LDS_BYTES, stream, a);
#else
    for (int ph = 0; ph < NPHASE; ++ph) { a.ph_lo = ph; a.ph_hi = ph + 1; hipLaunchKernelGGL(mega_fwd, dim3(grid), dim3(NTHR), LDS_BYTES, stream, a); }
#endif
}
```

```cpp
#include <hip/hip_runtime.h>
#include <cstdio>
#include <cstdint>

#define GAS __attribute__((address_space(1)))
#define LAS __attribute__((address_space(3)))
typedef unsigned short bf16;
typedef short bf16x8 __attribute__((ext_vector_type(8)));
typedef short s16x4 __attribute__((ext_vector_type(4)));
typedef float f32x4 __attribute__((ext_vector_type(4)));
typedef float f32x2 __attribute__((ext_vector_type(2)));
typedef float f32x16 __attribute__((ext_vector_type(16)));
typedef unsigned u32x4 __attribute__((ext_vector_type(4)));
typedef unsigned u32x2 __attribute__((ext_vector_type(2)));
typedef int i32x4 __attribute__((ext_vector_type(4)));
typedef int i32x8 __attribute__((ext_vector_type(8)));
typedef __bf16 bf16v2 __attribute__((ext_vector_type(2)));
typedef _Float16 h16x2 __attribute__((ext_vector_type(2)));

constexpr int T = 16384, D = 1024, SEQ = 2048, NBATCH = 8, NWAVES = 8, NTHR = 512;
constexpr float EPS = 1e-6f, LOG2E = 1.4426950408889634f;

__device__ __forceinline__ unsigned pk2(float lo, float hi) { f32x2 v = {lo, hi}; bf16v2 b = __builtin_convertvector(v, bf16v2); return __builtin_bit_cast(unsigned, b); }
__device__ __forceinline__ float bflo(unsigned w) { return __builtin_bit_cast(float, w << 16); }
__device__ __forceinline__ float bfhi(unsigned w) { return __builtin_bit_cast(float, w & 0xffff0000u); }
__device__ __forceinline__ float fexp2(float x) { return __builtin_amdgcn_exp2f(x); }
#define LDS_WAIT() asm volatile("s_waitcnt lgkmcnt(0)" ::: "memory")
__device__ __forceinline__ unsigned pk4_fp8(float a, float b, float c, float d) {
    a = __builtin_amdgcn_fmed3f(a, -448.f, 448.f); b = __builtin_amdgcn_fmed3f(b, -448.f, 448.f); c = __builtin_amdgcn_fmed3f(c, -448.f, 448.f); d = __builtin_amdgcn_fmed3f(d, -448.f, 448.f);
    int x = __builtin_amdgcn_cvt_pk_fp8_f32(a, b, 0, false); x = __builtin_amdgcn_cvt_pk_fp8_f32(c, d, x, true); return (unsigned)x;
}
__device__ __forceinline__ unsigned pk4_i8(float a, float b, float c, float d) {
    const int ia = (int)__builtin_rintf(__builtin_amdgcn_fmed3f(a, -127.f, 127.f)), ib = (int)__builtin_rintf(__builtin_amdgcn_fmed3f(b, -127.f, 127.f)), ic = (int)__builtin_rintf(__builtin_amdgcn_fmed3f(c, -127.f, 127.f)), id = (int)__builtin_rintf(__builtin_amdgcn_fmed3f(d, -127.f, 127.f));
    return ((unsigned)ia & 0xffu) | (((unsigned)ib & 0xffu) << 8) | (((unsigned)ic & 0xffu) << 16) | ((unsigned)id << 24);
}
constexpr float I8_XS = 32.f, I8_WS = 1024.f;
constexpr float V8_SCALE = 80.f;
constexpr float F8_XS = 16.f, F8_WS = 64.f;
typedef unsigned long long u64;
__device__ __forceinline__ void ssq_add(u64* p, float s) { atomicAdd(p, (u64)(s * 4294967296.f)); }
__device__ __forceinline__ float ssq_get(const u64* p) { return (float)(*p) * 2.3283064365386963e-10f; }

namespace pg8 {
constexpr int BM = 256, BK = 64, HALF = 128, HTB = HALF * BK * 2, STAGE_BYTES = 8 * HTB, NXCD = 8, WGM = 8;
__host__ __device__ __forceinline__ int lds_byte(int r, int c) { const int st = (r >> 4) * 2 + (c >> 5), rr = r & 15, cc = c & 31, ob = rr * 64 + cc * 2; return st * 1024 + (ob ^ (((ob >> 9) & 1) << 5)); }
__host__ __device__ __forceinline__ void stage_rc(int b, int& R, int& C) { const int st = b / 1024, sb = b % 1024, swz = sb ^ (((sb >> 9) & 1) << 5); R = (st >> 1) * 16 + swz / 64; C = (st & 1) * 32 + (swz % 64) / 2; }
__host__ __device__ __forceinline__ int perm32(int rho) { const int n = rho >> 4, i = rho & 15; return 8 * (i >> 2) + 4 * n + (i & 3); }
struct Unit { int pm, pn; };
struct Gemm { const bf16* A; const bf16* Bt; int M, N, K, lda, ldb; };
struct StaticOrder {
    int nM, nN, nwg, G, c;
    __device__ void init(int M, int N, int G_, int c_) { nM = M / BM; nN = N / BM; nwg = nM * nN; G = G_; c = c_; }
    __device__ bool next(int i, Unit& u) const {
        const long L = (long)i * G + c; if (L >= nwg) return false;
        int wgid = (int)L; { const int q = nwg / NXCD, r = nwg % NXCD, xcd = wgid % NXCD, off = wgid / NXCD; wgid = (xcd < r ? xcd * (q + 1) : r * (q + 1) + (xcd - r) * q) + off; }
        const int nig = WGM * nN, gid = wgid / nig, fm = gid * WGM, gsz = (nM - fm) < WGM ? (nM - fm) : WGM;
        u.pm = fm + ((wgid % nig) % gsz); u.pn = (wgid % nig) / gsz; return true;
    }
};
template <class Epi, bool F8 = false, bool I8 = false>
__device__ __forceinline__ void gemm_phase(LAS unsigned char* lds, const Gemm g, const StaticOrder& S, const Epi& E) {
    int tid_ = threadIdx.x; asm volatile("" : "+v"(tid_));
    const int tid = tid_, wid = __builtin_amdgcn_readfirstlane(tid >> 6), lane = tid & 63, wr = wid >> 2, wc = wid & 3, fr = lane & 15, fq = lane >> 4;
    const int K = g.K, nt = K / BK;
    unsigned voffA[2], voffB[2];
#pragma unroll
    for (int i = 0; i < 2; ++i) { int R, C; stage_rc(tid * 16 + i * 8192, R, C); const int Rb = Epi::HEADALIGN ? (64 * (R >> 5) + perm32(R & 31)) : ((R & ~31) + perm32(R & 31));
        voffA[i] = (unsigned)(R * g.lda + C) * 2u; voffB[i] = (unsigned)(Rb * g.ldb + C) * 2u; }
    const size_t kstep = (size_t)(BK * 2);
    const size_t hstepA = (size_t)HALF * g.lda * 2, hstepB = (size_t)(Epi::HEADALIGN ? 32 : HALF) * g.ldb * 2;
    const size_t tstepA = 2 * hstepA, tstepB = (size_t)BM * g.ldb * 2;
    const unsigned ldsw = (unsigned)wid * 1024u;
    const int aoff = lds_byte(wr * 64 + fr, fq * 8), boff = lds_byte(wc * 32 + fr, fq * 8);
    LAS unsigned char* ldsA = lds + aoff; LAS unsigned char* ldsB = lds + 4 * HTB + boff; asm volatile("" : "+v"(ldsA), "+v"(ldsB));
#define PG8_SA(b, h) (((b) * 2 + (h)) * HTB)
#define PG8_SB(b, h) ((4 + (b) * 2 + (h)) * HTB)
#define PG8_STAGE(bufoff, gbase, voff) do { _Pragma("unroll") for (int _i = 0; _i < 2; ++_i) \
        __builtin_amdgcn_global_load_lds((const unsigned*)((const char*)(gbase) + (voff)[_i]), (LAS unsigned*)(lds + (bufoff) + ldsw + _i * 8192), 16, 0, 0); } while (0)
#define PG8_LD8(p, off) __builtin_shufflevector(*(const LAS i32x4*)((p) + (off)), *(const LAS i32x4*)((p) + (off) + 1024), 0, 1, 2, 3, 4, 5, 6, 7)
#define PG8_LDA(dst, b, h) do { _Pragma("unroll") for (int m = 0; m < 4; ++m) { if (F8) dst##8[m] = PG8_LD8(ldsA, PG8_SA(b, h) + m * 2048); else { _Pragma("unroll") for (int k = 0; k < 2; ++k) dst[m][k] = *(const LAS bf16x8*)(ldsA + PG8_SA(b, h) + m * 2048 + k * 1024); } } } while (0)
#define PG8_LDB(dst, b, h) do { _Pragma("unroll") for (int n = 0; n < 2; ++n) { if (F8) dst##8[n] = PG8_LD8(ldsB, PG8_SA(b, h) + n * 2048); else { _Pragma("unroll") for (int k = 0; k < 2; ++k) dst[n][k] = *(const LAS bf16x8*)(ldsB + PG8_SA(b, h) + n * 2048 + k * 1024); } } } while (0)
#define PG8_MMA(ai, bj, At, Bt) do { __builtin_amdgcn_s_setprio(1); _Pragma("unroll") for (int m = 0; m < 4; ++m) _Pragma("unroll") for (int n = 0; n < 2; ++n) { \
        if (F8) asm volatile("v_mfma_f32_16x16x128_f8f6f4 %0, %1, %2, %0" : "+v"(acc[ai][bj][m][n]) : "v"(Bt##8[n]), "v"(At##8[m]));   \
        else if (I8) { _Pragma("unroll") for (int k = 0; k < 2; ++k) acc[ai][bj][m][n] = __builtin_bit_cast(f32x4, __builtin_amdgcn_mfma_i32_16x16x64_i8(__builtin_bit_cast(i32x4, Bt[n][k]), __builtin_bit_cast(i32x4, At[m][k]), __builtin_bit_cast(i32x4, acc[ai][bj][m][n]), 0, 0, 0)); } \
        else { _Pragma("unroll") for (int k = 0; k < 2; ++k) acc[ai][bj][m][n] = __builtin_amdgcn_mfma_f32_16x16x32_bf16(Bt[n][k], At[m][k], acc[ai][bj][m][n], 0, 0, 0); } } __builtin_amdgcn_s_setprio(0); } while (0)
#define PG8_WAIT_V(n) asm volatile("s_waitcnt vmcnt(" #n ")" ::: "memory")
#define PG8_WAIT_L(n) asm volatile("s_waitcnt lgkmcnt(" #n ")" ::: "memory")
#define PG8_BAR __builtin_amdgcn_s_barrier()
#define PG8_SCHED __builtin_amdgcn_sched_barrier(0)
    Unit cur, nxt; int ui = 0;
    if (!S.next(0, cur)) return;
    f32x4 acc[2][2][4][2];
#pragma unroll
    for (int a = 0; a < 2; ++a)
#pragma unroll
        for (int b = 0; b < 2; ++b)
#pragma unroll
            for (int m = 0; m < 4; ++m)
#pragma unroll
                for (int n = 0; n < 2; ++n) acc[a][b][m][n] = (f32x4){0.f, 0.f, 0.f, 0.f};
    bf16x8 At[4][2], B0[2][2], B1[2][2]; i32x8 At8[4], B08[2], B18[2];
    const char* cA = (const char*)g.A + (size_t)cur.pm * tstepA; const char* cB = (const char*)g.Bt + (size_t)cur.pn * tstepB;
    PG8_STAGE(PG8_SB(0, 0), cB, voffB); PG8_STAGE(PG8_SB(0, 1), cB + hstepB, voffB); PG8_STAGE(PG8_SA(0, 0), cA, voffA); PG8_STAGE(PG8_SA(0, 1), cA + hstepA, voffA);
    if (wr == 1) PG8_BAR;
    PG8_WAIT_V(2); PG8_BAR;
    PG8_STAGE(PG8_SB(1, 0), cB + kstep, voffB); PG8_STAGE(PG8_SA(1, 0), cA + kstep, voffA); PG8_STAGE(PG8_SB(1, 1), cB + hstepB + kstep, voffB);
    PG8_WAIT_V(6); PG8_BAR;
    for (;;) {
        const bool has_next = S.next(ui + 1, nxt);
        const char* nA = has_next ? (const char*)g.A + (size_t)nxt.pm * tstepA : cA; const char* nB = has_next ? (const char*)g.Bt + (size_t)nxt.pn * tstepB : cB;
#pragma unroll 1
        for (int t = 0; t < nt; t += 2) {
            const bool last = (t == nt - 2);
            const char* a1 = cA + (size_t)(t + 1) * kstep;
            const char* a2 = last ? nA : cA + (size_t)(t + 2) * kstep; const char* b2 = last ? nB : cB + (size_t)(t + 2) * kstep;
            const char* a3 = a2 + kstep; const char* b3 = b2 + kstep;
            PG8_LDB(B0, 0, 0); PG8_LDB(B1, 0, 1); PG8_SCHED; PG8_LDA(At, 0, 0); PG8_STAGE(PG8_SA(1, 1), a1 + hstepA, voffA);
            PG8_WAIT_V(8); PG8_WAIT_L(0); PG8_BAR; PG8_MMA(0, 0, At, B0); PG8_MMA(0, 1, At, B1); PG8_BAR; PG8_SCHED;
            PG8_LDA(At, 0, 1); PG8_STAGE(PG8_SB(0, 0), b2, voffB); PG8_STAGE(PG8_SB(0, 1), b2 + hstepB, voffB); PG8_STAGE(PG8_SA(0, 0), a2, voffA);
            PG8_WAIT_V(8); PG8_WAIT_L(0); PG8_BAR; PG8_MMA(1, 0, At, B0); PG8_MMA(1, 1, At, B1); PG8_BAR; PG8_SCHED;
            PG8_LDB(B0, 1, 0); PG8_LDB(B1, 1, 1); PG8_SCHED; PG8_LDA(At, 1, 0); PG8_STAGE(PG8_SA(0, 1), a2 + hstepA, voffA);
            PG8_WAIT_V(8); PG8_WAIT_L(0); PG8_BAR; PG8_MMA(0, 0, At, B0); PG8_MMA(0, 1, At, B1); PG8_BAR; PG8_SCHED;
            PG8_LDA(At, 1, 1); PG8_STAGE(PG8_SB(1, 0), b3, voffB); PG8_STAGE(PG8_SB(1, 1), b3 + hstepB, voffB); PG8_STAGE(PG8_SA(1, 0), a3, voffA);
            PG8_WAIT_V(8); PG8_WAIT_L(0); PG8_BAR; PG8_MMA(1, 0, At, B0); PG8_MMA(1, 1, At, B1); PG8_BAR; PG8_SCHED;
        }
        if (wr == 0) PG8_BAR;
        if (F8) asm volatile("s_nop 15\n\ts_nop 7" ::: "memory");
        E(acc, cur, wr, wc, fr, fq);
        if (!has_next) break;
#pragma unroll
        for (int a = 0; a < 2; ++a)
#pragma unroll
            for (int b = 0; b < 2; ++b)
#pragma unroll
                for (int m = 0; m < 4; ++m)
#pragma unroll
                    for (int n = 0; n < 2; ++n) acc[a][b][m][n] = (f32x4){0.f, 0.f, 0.f, 0.f};
        cur = nxt; cA = nA; cB = nB; ++ui;
        if (wr == 1) PG8_BAR;
    }
    PG8_WAIT_V(0);
    PG8_BAR;
#undef PG8_SA
#undef PG8_SB
#undef PG8_STAGE
#undef PG8_LDA
#undef PG8_LDB
#undef PG8_MMA
#undef PG8_LD8
#undef PG8_WAIT_V
#undef PG8_WAIT_L
#undef PG8_BAR
#undef PG8_SCHED
}

struct EpiRowBf16 {
    static constexpr bool HEADALIGN = false;
    bf16* O; int ldc; const float* stat; const u64* statq; float inv_n; int mode;
    u64* ssqA; u64* ssqB; int a_lo, a_hi, b_lo, b_hi;
    __device__ __forceinline__ void operator()(const f32x4 (&acc)[2][2][4][2], const Unit& u, int wr, int wc, int fr, int fq) const {
        const int row0 = u.pm * BM + wr * 64 + fr, col0 = u.pn * BM + wc * 32 + 8 * fq;
#pragma unroll
        for (int ai = 0; ai < 2; ++ai)
#pragma unroll
            for (int m = 0; m < 4; ++m) {
                const int row = row0 + ai * HALF + m * 16;
                float sc; if (mode == 2) sc = 1.f; else if (mode) sc = __builtin_amdgcn_rsqf(ssq_get(statq + row) * inv_n + EPS); else sc = stat[row];
                bf16* rowp = O + (size_t)row * ldc + col0;
#pragma unroll
                for (int bj = 0; bj < 2; ++bj) {
                    const f32x4 v0 = acc[ai][bj][m][0] * sc, v1 = acc[ai][bj][m][1] * sc;
                    u32x4 w; w.x = pk2(v0[0], v0[1]); w.y = pk2(v0[2], v0[3]); w.z = pk2(v1[0], v1[1]); w.w = pk2(v1[2], v1[3]);
                    *(u32x4*)(rowp + bj * HALF) = w;
                    if (ssqA) {
                        const int hidx = u.pn * 2 + bj;
                        u64* dst = (hidx >= a_lo && hidx < a_hi) ? ssqA : ((hidx >= b_lo && hidx < b_hi) ? ssqB : nullptr);
                        if (dst) {
                            float s = v0[0] * v0[0] + v0[1] * v0[1] + v0[2] * v0[2] + v0[3] * v0[3] + v1[0] * v1[0] + v1[1] * v1[1] + v1[2] * v1[2] + v1[3] * v1[3];
                            s += __shfl_xor(s, 16); s += __shfl_xor(s, 32);
                            if (fq == 0) ssq_add(dst + row, s);
                        }
                    }
                }
            }
    }
};
struct EpiPlainBf16 {
    static constexpr bool HEADALIGN = false;
    bf16* O; int ldc;
    __device__ __forceinline__ void operator()(const f32x4 (&acc)[2][2][4][2], const Unit& u, int wr, int wc, int fr, int fq) const {
        asm volatile("" : "+v"(fr), "+v"(fq));
        bf16* base = O + (size_t)(u.pm * BM + wr * 64 + fr) * ldc + u.pn * BM + wc * 32 + 8 * fq;
#pragma unroll
        for (int ai = 0; ai < 2; ++ai)
#pragma unroll
            for (int m = 0; m < 4; ++m)
#pragma unroll
                for (int bj = 0; bj < 2; ++bj) { const f32x4 v0 = acc[ai][bj][m][0], v1 = acc[ai][bj][m][1];
                    u32x4 w; w.x = pk2(v0[0], v0[1]); w.y = pk2(v0[2], v0[3]); w.z = pk2(v1[0], v1[1]); w.w = pk2(v1[2], v1[3]);
                    *(u32x4*)(base + (size_t)(ai * HALF + m * 16) * ldc + bj * HALF) = w; }
    }
};
struct EpiResid {
    static constexpr bool HEADALIGN = false;
    bf16* xb; unsigned char* xq; u64* ssq; float mul;
    __device__ __forceinline__ void operator()(const f32x4 (&acc)[2][2][4][2], const Unit& u, int wr, int wc, int fr, int fq) const {
        const int row0 = u.pm * BM + wr * 64 + fr, col0 = u.pn * BM + wc * 32 + 8 * fq;
#pragma unroll
        for (int ai = 0; ai < 2; ++ai)
#pragma unroll
            for (int m = 0; m < 4; ++m) {
                const int row = row0 + ai * HALF + m * 16; const size_t off = (size_t)row * D + col0;
                float s = 0.f;
#pragma unroll
                for (int bj = 0; bj < 2; ++bj) {
                    const u32x4 xr = *(const u32x4*)(xb + off + bj * HALF);
                    const f32x4 x0 = {bflo(xr.x), bfhi(xr.x), bflo(xr.y), bfhi(xr.y)}, x1 = {bflo(xr.z), bfhi(xr.z), bflo(xr.w), bfhi(xr.w)};
                    const f32x4 v0 = acc[ai][bj][m][0] * mul + x0, v1 = acc[ai][bj][m][1] * mul + x1;
                    u32x4 w; w.x = pk2(v0[0], v0[1]); w.y = pk2(v0[2], v0[3]); w.z = pk2(v1[0], v1[1]); w.w = pk2(v1[2], v1[3]);
                    *(u32x4*)(xb + off + bj * HALF) = w;
                    { u32x2 w8; w8.x = pk4_i8(v0[0] * I8_XS, v0[1] * I8_XS, v0[2] * I8_XS, v0[3] * I8_XS); w8.y = pk4_i8(v1[0] * I8_XS, v1[1] * I8_XS, v1[2] * I8_XS, v1[3] * I8_XS); *(u32x2*)(xq + off + bj * HALF) = w8; }
                    s += v0[0] * v0[0] + v0[1] * v0[1] + v0[2] * v0[2] + v0[3] * v0[3] + v1[0] * v1[0] + v1[1] * v1[1] + v1[2] * v1[2] + v1[3] * v1[3];
                }
                s += __shfl_xor(s, 16); s += __shfl_xor(s, 32);
                if (fq == 0) ssq_add(ssq + row, s);
            }
    }
};
struct EpiQKVNorm {
    static constexpr bool HEADALIGN = true;
    bf16* C3; size_t cstride; const u64* ssq; const float* gq; const float* gk; float osc;
    __device__ __forceinline__ void operator()(const f32x4 (&acc)[2][2][4][2], const Unit& u, int wr, int wc, int fr, int fq) const {
        const int which = u.pn >> 2, head = (u.pn & 3) * 4 + wc;
        bf16* dst = C3 + (size_t)which * cstride;
        f32x4 gv[2][2];
#pragma unroll
        for (int bj = 0; bj < 2; ++bj)
#pragma unroll
            for (int n = 0; n < 2; ++n) { const f32x4 a = *(const f32x4*)(gq + 32 * bj + 8 * fq + 4 * n), b = *(const f32x4*)(gk + 32 * bj + 8 * fq + 4 * n);
                gv[bj][n] = which == 0 ? a : (which == 1 ? b : (f32x4){1.f, 1.f, 1.f, 1.f}); }
        const float post = which == 0 ? 0.125f * LOG2E : 1.f;
        const int row0 = u.pm * BM + wr * 64 + fr;
#pragma unroll
        for (int ai = 0; ai < 2; ++ai)
#pragma unroll
            for (int m = 0; m < 4; ++m) {
                const int row = row0 + ai * HALF + m * 16;
                const float sc = __builtin_amdgcn_rsqf(ssq_get(ssq + row) * (1.f / D) + EPS) * osc;
                f32x4 v[2][2]; float ss = 0.f;
#pragma unroll
                for (int bj = 0; bj < 2; ++bj)
#pragma unroll
                    for (int n = 0; n < 2; ++n) { v[bj][n] = acc[ai][bj][m][n] * sc; ss += v[bj][n][0] * v[bj][n][0] + v[bj][n][1] * v[bj][n][1] + v[bj][n][2] * v[bj][n][2] + v[bj][n][3] * v[bj][n][3]; }
                ss += __shfl_xor(ss, 16); ss += __shfl_xor(ss, 32);
                const float r = which == 2 ? 1.f : __builtin_amdgcn_rsqf(ss * (1.f / 64.f) + EPS) * post;
                bf16* rowp = dst + (size_t)row * 1024 + head * 64 + 8 * fq;
#pragma unroll
                for (int bj = 0; bj < 2; ++bj) { const f32x4 a = v[bj][0] * gv[bj][0] * r, b = v[bj][1] * gv[bj][1] * r;
                    u32x4 w; w.x = pk2(a[0], a[1]); w.y = pk2(a[2], a[3]); w.z = pk2(b[0], b[1]); w.w = pk2(b[2], b[3]);
                    *(u32x4*)(rowp + 32 * bj) = w; }
            }
    }
};
struct EpiProj0 {
    static constexpr bool HEADALIGN = true;
    bf16* O; const float* rstd; u64* ssq_cq; u64* ssq_ckv; u64* ssq_pe; const float* gq; const float* gk; float osc;
    __device__ __forceinline__ void operator()(const f32x4 (&acc)[2][2][4][2], const Unit& u, int wr, int wc, int fr, int fq) const {
        const int colw = u.pn * BM + wc * 64;
        const int kind = colw < 640 ? 0 : (colw < 1152 ? 1 : (colw < 1280 ? 2 : (colw < 1408 ? 3 : 4)));
        f32x4 gv[2][2];
#pragma unroll
        for (int bj = 0; bj < 2; ++bj)
#pragma unroll
            for (int n = 0; n < 2; ++n) { const f32x4 a = *(const f32x4*)(gq + 32 * bj + 8 * fq + 4 * n), b = *(const f32x4*)(gk + 32 * bj + 8 * fq + 4 * n);
                gv[bj][n] = kind == 1 ? a * (0.125f * LOG2E) : (kind == 2 ? b : (f32x4){1.f, 1.f, 1.f, 1.f}); }
        const int row0 = u.pm * BM + wr * 64 + fr;
#pragma unroll
        for (int ai = 0; ai < 2; ++ai)
#pragma unroll
            for (int m = 0; m < 4; ++m) {
                const int row = row0 + ai * HALF + m * 16;
                const float sc = rstd[row] * osc;
                f32x4 v[2][2]; float s0 = 0.f, s1 = 0.f;
#pragma unroll
                for (int n = 0; n < 2; ++n) { v[0][n] = acc[ai][0][m][n] * sc; v[1][n] = acc[ai][1][m][n] * sc;
                    s0 += v[0][n][0] * v[0][n][0] + v[0][n][1] * v[0][n][1] + v[0][n][2] * v[0][n][2] + v[0][n][3] * v[0][n][3];
                    s1 += v[1][n][0] * v[1][n][0] + v[1][n][1] * v[1][n][1] + v[1][n][2] * v[1][n][2] + v[1][n][3] * v[1][n][3]; }
                s0 += __shfl_xor(s0, 16); s0 += __shfl_xor(s0, 32); s1 += __shfl_xor(s1, 16); s1 += __shfl_xor(s1, 32);
                float r = 1.f;
                if (kind == 0) { if (fq == 0) { ssq_add((colw < 384 ? ssq_cq : ssq_ckv) + row, s0 + s1); } }
                else if (kind == 4) { if (fq == 0 && colw == 1408) ssq_add(ssq_pe + row, s0); }
                else if (kind != 3) r = __builtin_amdgcn_rsqf((s0 + s1) * (1.f / 64.f) + EPS);
                bf16* rowp = O + (size_t)row * 1536 + colw + 8 * fq;
#pragma unroll
                for (int bj = 0; bj < 2; ++bj) { const f32x4 a = v[bj][0] * gv[bj][0] * r, b = v[bj][1] * gv[bj][1] * r;
                    u32x4 w; w.x = pk2(a[0], a[1]); w.y = pk2(a[2], a[3]); w.z = pk2(b[0], b[1]); w.w = pk2(b[2], b[3]);
                    *(u32x4*)(rowp + 32 * bj) = w; }
            }
    }
};
struct EpiKVNorm {
    static constexpr bool HEADALIGN = true;
    bf16* Km; bf16* Vm; const bf16* proj; const u64* ssq_ckv; const u64* ssq_pe; const float* gk; const float* rope;
    __device__ __forceinline__ void operator()(const f32x4 (&acc)[2][2][4][2], const Unit& u, int wr, int wc, int fr, int fq) const {
        asm volatile("" : "+v"(fr), "+v"(fq));
        const int head = u.pn * 2 + (wc >> 1), part = wc & 1;
        const int row0 = u.pm * BM + wr * 64 + fr;
        float rr[8], scv[8], pev[8];
#pragma unroll
        for (int q = 0; q < 8; ++q) { const int row = row0 + (q >> 2) * HALF + (q & 3) * 16; scv[q] = ssq_get(ssq_ckv + row); pev[q] = ssq_get(ssq_pe + row); }
#pragma unroll
        for (int ai = 0; ai < 2; ++ai)
#pragma unroll
            for (int m = 0; m < 4; ++m) {
                const int row = row0 + ai * HALF + m * 16;
                const float sc = __builtin_amdgcn_rsqf(scv[ai * 4 + m] * (1.f / 256.f) + EPS);
                f32x4 v[2][2]; float ss = 0.f;
#pragma unroll
                for (int bj = 0; bj < 2; ++bj)
#pragma unroll
                    for (int n = 0; n < 2; ++n) { v[bj][n] = acc[ai][bj][m][n] * sc; ss += v[bj][n][0] * v[bj][n][0] + v[bj][n][1] * v[bj][n][1] + v[bj][n][2] * v[bj][n][2] + v[bj][n][3] * v[bj][n][3]; }
                ss += __shfl_xor(ss, 16); ss += __shfl_xor(ss, 32);
                const float r = part ? 1.f : __builtin_amdgcn_rsqf((ss + pev[ai * 4 + m]) * (1.f / 96.f) + EPS);
                rr[ai * 4 + m] = r;
                bf16* rowp = part ? Vm + (size_t)row * 512 + head * 64 + 8 * fq : Km + (size_t)row * 768 + head * 96 + 8 * fq;
#pragma unroll
                for (int bj = 0; bj < 2; ++bj) { const f32x4 ga = part ? (f32x4){1.f, 1.f, 1.f, 1.f} : *(const f32x4*)(gk + 32 * bj + 8 * fq), gb = part ? (f32x4){1.f, 1.f, 1.f, 1.f} : *(const f32x4*)(gk + 32 * bj + 8 * fq + 4);
                    const f32x4 a = v[bj][0] * ga * r, b = v[bj][1] * gb * r;
                    u32x4 w; w.x = pk2(a[0], a[1]); w.y = pk2(a[2], a[3]); w.z = pk2(b[0], b[1]); w.w = pk2(b[2], b[3]);
                    *(u32x4*)(rowp + 32 * bj) = w; }
                __builtin_amdgcn_sched_barrier(0);
            }
        if (part == 0) {
            const f32x4 g1 = *(const f32x4*)(gk + 64 + 4 * fq), g2 = *(const f32x4*)(gk + 80 + 4 * fq);
#pragma unroll
            for (int q = 0; q < 8; ++q) {
                const int row = row0 + (q >> 2) * HALF + (q & 3) * 16; const float r = rr[q];
                const u32x2 p1 = *(const u32x2*)(proj + (size_t)row * 1536 + 1408 + 4 * fq), p2 = *(const u32x2*)(proj + (size_t)row * 1536 + 1424 + 4 * fq);
                const float* cs = rope + (row & (SEQ - 1)) * 16 + 4 * fq;
                const f32x4 c = *(const f32x4*)cs, sn = *(const f32x4*)(cs + 32768);
                const f32x4 x1 = (f32x4){bflo(p1.x), bfhi(p1.x), bflo(p1.y), bfhi(p1.y)} * g1 * r, x2 = (f32x4){bflo(p2.x), bfhi(p2.x), bflo(p2.y), bfhi(p2.y)} * g2 * r;
                const f32x4 o1 = x1 * c - x2 * sn, o2 = x1 * sn + x2 * c;
                bf16* kp = Km + (size_t)row * 768 + head * 96 + 64 + 4 * fq;
                u32x2 w1, w2; w1.x = pk2(o1[0], o1[1]); w1.y = pk2(o1[2], o1[3]); w2.x = pk2(o2[0], o2[1]); w2.y = pk2(o2[2], o2[3]);
                *(u32x2*)kp = w1; *(u32x2*)(kp + 16) = w2;
            }
        }
    }
};
struct EpiScoreT {
    static constexpr bool HEADALIGN = false;
    unsigned* scT; const u64* ssq; float osc;
    __device__ __forceinline__ void operator()(const f32x4 (&acc)[2][2][4][2], const Unit& u, int wr, int wc, int fr, int fq) const {
        const int c8 = u.pn * 32 + wc * 4 + fq;
#pragma unroll
        for (int ai = 0; ai < 2; ++ai) {
            const int g = u.pm * 4 + ai * 2 + wr;
#pragma unroll
            for (int m = 0; m < 4; ++m) {
                const int row = m * 16 + fr;
                const float sc = __builtin_amdgcn_rsqf(ssq_get(ssq + g * 64 + row) * (1.f / D) + EPS) * osc;
#pragma unroll
                for (int bj = 0; bj < 2; ++bj) {
                    const i32x4 v0 = __builtin_bit_cast(i32x4, acc[ai][bj][m][0]), v1 = __builtin_bit_cast(i32x4, acc[ai][bj][m][1]);
                    u32x4 w; w.x = pk2((float)v0[0] * sc, (float)v0[1] * sc); w.y = pk2((float)v0[2] * sc, (float)v0[3] * sc); w.z = pk2((float)v1[0] * sc, (float)v1[1] * sc); w.w = pk2((float)v1[2] * sc, (float)v1[3] * sc);
#pragma unroll
                    for (int q = 0; q < 4; ++q) w[q] ^= ((w[q] >> 15) & 0x00010001u) * 0x7fffu;
                    *(u32x4*)(scT + (((size_t)g * 256 + c8 + 16 * bj) * 64 + row) * 4) = w;
                }
            }
        }
    }
};
}

constexpr size_t MiB = 1u << 20;
constexpr size_t WS_CTL = 0, CTL_ZERO_BYTES = 1024 * 1024;
constexpr size_t CTL_SSQ_CQ = 128 * 1024, CTL_SSQ_CKV = 256 * 1024, CTL_SSQ_X1 = 384 * 1024, CTL_SSQ_X3 = 512 * 1024, CTL_SSQ_X2 = 640 * 1024, CTL_SSQ_PE = 768 * 1024;
constexpr int CW_BAR = 4096, CW_RANK = 8192;
constexpr size_t WS_RSTD0 = 1 * MiB, WS_RSTD2 = WS_RSTD0 + 65536, WS_ROPE = WS_RSTD2 + 65536  , WS_T5TAB = WS_ROPE + 262144  , WS_CATAB = WS_T5TAB + 8192  , WS_MQK = WS_CATAB + 20480  ;
constexpr size_t WS_W0T = 2 * MiB, WS_WUQT = 5 * MiB, WS_WUKVT = 6 * MiB, WS_WOUT0T = 7 * MiB, WS_W1T = 9 * MiB, WS_WOUT1T = 15 * MiB, WS_WPQT = 17 * MiB;
constexpr size_t WS_EIDX = 25 * MiB, WS_EW = 33 * MiB, WS_XB = 41 * MiB, WS_XA = 73 * MiB, WS_BIG = 137 * MiB, WS_ATT = 265 * MiB, WS_TAB = 361 * MiB, WS_PW = 425 * MiB, WS_MIX = 433 * MiB, WS_PKA = 465 * MiB  , WS_END = 489 * MiB;
constexpr size_t BIG_PROJ = 0, BIG_QRAW = 48 * MiB, BIG_KVRAW = 72 * MiB, BIG_MIX = 96 * MiB;
constexpr size_t ATT_QM = 0, ATT_KM = 24 * MiB, ATT_VMT = 48 * MiB, ATT_SQ = 64 * MiB, ATT_SK = 80 * MiB, ATT_SVT = 84 * MiB;
constexpr size_t ATT_CQ = 0, ATT_CK = 32 * MiB, ATT_CVT = 64 * MiB;
constexpr int RING_BYTES = 131072, MISC_OFF = RING_BYTES + 320, LDS_BYTES = 147456;

#define XB_TMO      128
#define XB_XCNT(j)  (256  + 64 * (j))
#define XB_XSUB(j)  (1280 + 64 * (j))
#define XB_XGEN(j)  (2304 + 64 * (j))
#define XB_TOP      3328
#define XB_TOPGEN   3392
#define XCD_BAR_WORDS 3456
#define XB_SPIN_CAP (1u << 18)
__device__ __forceinline__ unsigned xb_ld(unsigned* p)              { return __hip_atomic_load(p, __ATOMIC_RELAXED, __HIP_MEMORY_SCOPE_AGENT); }
__device__ __forceinline__ unsigned xb_add(unsigned* p, unsigned v) { return __hip_atomic_fetch_add(p, v, __ATOMIC_RELAXED, __HIP_MEMORY_SCOPE_AGENT); }
__device__ __forceinline__ unsigned xb_xcc_id() { return (unsigned)__builtin_amdgcn_s_getreg((3 << 11) | 20) & 0xFu; }
#define XB_SPIN(cond, bar) do { unsigned _sp = 0; while (cond) { __builtin_amdgcn_s_sleep(1); \
    if ((++_sp & 255u) == 0u) { if (xb_ld(&(bar)[XB_TMO])) break; if (_sp > XB_SPIN_CAP) { atomicAdd(&(bar)[XB_TMO], 1u); break; } } } } while (0)
struct XcdBarrier { unsigned* bar; unsigned x; volatile LAS unsigned* st; };
__device__ __forceinline__ XcdBarrier xcd_barrier_post(unsigned* bar, volatile LAS unsigned* st) {
    XcdBarrier b; b.bar = bar; b.x = xb_xcc_id(); b.st = st;
    if (threadIdx.x == 0) (void)xb_add(&bar[XB_XCNT(b.x)], 1u);
    return b;
}
__device__ __forceinline__ void xcd_barrier_complete(unsigned* bar, unsigned x, unsigned& nloc, unsigned& nx) {
    const unsigned G = gridDim.x * gridDim.y * gridDim.z;
    unsigned sum, cnt, mine, sp = 0u;
    for (;;) {
        sum = 0u; cnt = 0u; mine = 0u;
#pragma unroll
        for (unsigned j = 0; j < 16; ++j) { const unsigned c = xb_ld(&bar[XB_XCNT(j)]); sum += c; cnt += (c > 0u) ? 1u : 0u; mine = (j == x) ? c : mine; }
        if (sum == G) break;
        __builtin_amdgcn_s_sleep(1);
        if ((++sp & 255u) == 0u) { if (xb_ld(&bar[XB_TMO])) break; if (sp > XB_SPIN_CAP) { atomicAdd(&bar[XB_TMO], 1u); break; } }
    }
    nloc = mine > 0u ? mine : 1u; nx = cnt > 0u ? cnt : 1u;
}
__device__ __forceinline__ void xcd_barrier(const XcdBarrier& b) {
    asm volatile("s_waitcnt vmcnt(0)" ::: "memory");
    __syncthreads();
    if (threadIdx.x == 0) {
        unsigned* bar = b.bar;
        __builtin_amdgcn_s_waitcnt(0);
        unsigned nloc = b.st[0], nx = b.st[1];
        if (nloc == 0u) { xcd_barrier_complete(bar, b.x, nloc, nx); b.st[0] = nloc; b.st[1] = nx; }
        const unsigned old = xb_add(&bar[XB_XSUB(b.x)], 1u);
        const unsigned gen = old / nloc;
        if (old + 1u == (gen + 1u) * nloc) {
            __builtin_amdgcn_fence(__ATOMIC_RELEASE, "agent");
            asm volatile("s_waitcnt vmcnt(0)" ::: "memory");
            const unsigned og = xb_add(&bar[XB_TOP], 1u);
            const unsigned tg = og / nx;
            if (og + 1u == (tg + 1u) * nx) xb_add(&bar[XB_TOPGEN], 1u);
            else XB_SPIN(xb_ld(&bar[XB_TOPGEN]) == tg, bar);
            __builtin_amdgcn_fence(__ATOMIC_ACQUIRE, "agent");
            xb_add(&bar[XB_XGEN(b.x)], 1u);
            asm volatile("s_waitcnt vmcnt(0)" ::: "memory");
        } else {
            XB_SPIN(xb_ld(&bar[XB_XGEN(b.x)]) == gen, bar);
            __builtin_amdgcn_fence(__ATOMIC_ACQUIRE, "agent");
            asm volatile("s_waitcnt vmcnt(0)" ::: "memory");
        }
    }
    __syncthreads();
}

template <int CTRL> __device__ __forceinline__ float dpp_f(float v) { return __builtin_bit_cast(float, __builtin_amdgcn_update_dpp(0, __builtin_bit_cast(int, v), CTRL, 0xf, 0xf, true)); }
__device__ __forceinline__ float row_sum16(float v) {
    v += dpp_f<0xB1>(v); v += dpp_f<0x4E>(v); v += dpp_f<0x141>(v); v += dpp_f<0x140>(v); return v;
}
__device__ __forceinline__ float wave_sum(float v) {
    v = row_sum16(v);
    const int vi = __builtin_bit_cast(int, v);
    return __builtin_bit_cast(float, __builtin_amdgcn_readlane(vi, 0)) + __builtin_bit_cast(float, __builtin_amdgcn_readlane(vi, 16)) + __builtin_bit_cast(float, __builtin_amdgcn_readlane(vi, 32)) + __builtin_bit_cast(float, __builtin_amdgcn_readlane(vi, 48));
}
__device__ __forceinline__ float gelu_tanh(float x) {
    const float u = 0.7978845608028654f * (x + 0.044715f * x * x * x);
    return x * __builtin_amdgcn_rcpf(1.f + fexp2(-2.f * LOG2E * u));
}

__device__ __forceinline__ void p0_transpose_item(const float* W, const float* gain, int K, int N, bf16* WT, LAS float* scr, int item, int lane, bool permW0 = false, bool f8 = false) {
    const int nblk = N / 32, kb = item / nblk, nb = item % nblk, k0 = 64 * kb, n0 = 32 * nb;
    const int n0d = !permW0 ? n0 : (n0 < 640 ? n0 : (n0 < 672 ? n0 + 768 : n0 - 32));
#pragma unroll 8
    for (int i = 0; i < 32; ++i) { const int kk = 2 * i + (lane >> 5); float w = __builtin_nontemporal_load(W + (size_t)(k0 + kk) * N + n0 + (lane & 31)); if (gain) w *= gain[k0 + kk]; scr[kk * 33 + (lane & 31)] = w; }
    LDS_WAIT(); asm volatile("" ::: "memory");
    const int c = lane & 7;
#pragma unroll
    for (int j = 0; j < 4; ++j) { const int n = (lane >> 3) + 8 * j; const LAS float* s = scr + (8 * c) * 33 + n;
        u32x4 o; o.x = pk2(s[0 * 33], s[1 * 33]); o.y = pk2(s[2 * 33], s[3 * 33]); o.z = pk2(s[4 * 33], s[5 * 33]); o.w = pk2(s[6 * 33], s[7 * 33]);
        if (!f8) *(u32x4*)(WT + (size_t)(n0d + n) * K + k0 + 8 * c) = o;
        else { u32x2 o8; o8.x = pk4_fp8(s[0 * 33] * F8_WS, s[1 * 33] * F8_WS, s[2 * 33] * F8_WS, s[3 * 33] * F8_WS); o8.y = pk4_fp8(s[4 * 33] * F8_WS, s[5 * 33] * F8_WS, s[6 * 33] * F8_WS, s[7 * 33] * F8_WS);
               *(u32x2*)((unsigned char*)WT + (size_t)(n0d + n) * K + k0 + 8 * c) = o8; } }
    LDS_WAIT(); asm volatile("" ::: "memory");
}

struct Ptrs {
    const float* in[24]; float* out; unsigned char* ws;
};

__device__ __forceinline__ void p0_prologue(const Ptrs& P, LAS unsigned char* lds, int tid, int lane, int wave) {
    unsigned char* ws = P.ws;
    const int G = gridDim.x;
    const size_t gtid = (size_t)blockIdx.x * NTHR + tid, gthreads = (size_t)G * NTHR;
#pragma unroll 1
    for (int pass = 0; pass < 2; ++pass) {
      if (((blockIdx.x & 1) == 0) == (pass == 0)) {
    {
        const int gw = blockIdx.x * NWAVES + wave, NGW = G * NWAVES;
        for (int a = 0; a < 4; ++a) {
            const int l = a >> 1, isv = a & 1; const float psc = isv ? V8_SCALE : 96.f;
            const float* srcf = P.in[22 + isv] + (size_t)l * 16384 * 1024;
            unsigned char* dstb = ws + WS_TAB + (size_t)l * 32 * MiB + (size_t)isv * 16 * MiB;
            for (int e0 = gw * 4; e0 < 16384; e0 += NGW * 4) {
                f32x4 v[4][4];
#pragma unroll
                for (int r = 0; r < 4; ++r)
#pragma unroll
                    for (int q = 0; q < 4; ++q) v[r][q] = __builtin_nontemporal_load((const f32x4*)(srcf + (size_t)(e0 + r) * 1024 + q * 256) + lane);
#pragma unroll
                for (int r = 0; r < 4; ++r) {
                    unsigned w[4];
#pragma unroll
                    for (int q = 0; q < 4; ++q) { const f32x4 vv = v[r][q] * psc; unsigned x = 0u;
                        if (isv) {
#pragma unroll
                            for (int j = 0; j < 4; ++j) x |= ((unsigned)(int)__builtin_rintf(__builtin_amdgcn_fmed3f(vv[j], -127.f, 127.f)) & 0xffu) << (8 * j);
                        } else {
#pragma unroll
                            for (int j = 0; j < 4; ++j) { const int qi = (int)__builtin_rintf(fminf(fmaxf(vv[j], -8.f), 7.f)); x |= ((unsigned)qi & 0xfu) << (4 * j); }
                        }
                        w[q] = x; }
                    { const int jq = lane & 3; const bool odd = (jq & 1) != 0, hi = (jq & 2) != 0;
                      { const unsigned s0 = odd ? w[0] : w[1], s1 = odd ? w[2] : w[3];
                        const unsigned r0 = (unsigned)__builtin_amdgcn_update_dpp(0, (int)s0, 0xB1, 0xf, 0xf, true), r1 = (unsigned)__builtin_amdgcn_update_dpp(0, (int)s1, 0xB1, 0xf, 0xf, true);
                        w[0] = odd ? r0 : w[0]; w[1] = odd ? w[1] : r0; w[2] = odd ? r1 : w[2]; w[3] = odd ? w[3] : r1; }
                      { const unsigned s0 = hi ? w[0] : w[2], s1 = hi ? w[1] : w[3];
                        const unsigned r0 = (unsigned)__builtin_amdgcn_update_dpp(0, (int)s0, 0x4E, 0xf, 0xf, true), r1 = (unsigned)__builtin_amdgcn_update_dpp(0, (int)s1, 0x4E, 0xf, 0xf, true);
                        w[0] = hi ? r0 : w[0]; w[2] = hi ? w[2] : r0; w[1] = hi ? r1 : w[1]; w[3] = hi ? w[3] : r1; }
                      const int a4 = lane >> 2;
                      if (isv) { const size_t sl = 2 * jq + (a4 >> 3);
                          __builtin_nontemporal_store((u32x4){w[0], w[1], w[2], w[3]}, (u32x4*)(dstb + ((sl * 16384 + (size_t)(e0 + r)) * 128 + ((16 * a4) & 127)))); }
                      else { u32x2 o2; o2.x = (w[0] & 0xffffu) | (w[1] << 16); o2.y = (w[2] & 0xffffu) | (w[3] << 16);
                          __builtin_nontemporal_store(o2, (u32x2*)(dstb + (((size_t)jq * 16384 + (size_t)(e0 + r)) * 128 + 8 * a4))); } }
                }
            }
        }
    }
    {
        const int gw = blockIdx.x * NWAVES + wave, NGW = G * NWAVES;
        for (int t = gw; t < T; t += NGW) {
            const f32x4* xr = (const f32x4*)(P.in[0] + (size_t)t * D) + lane;
            f32x4 v[4]; float s = 0.f;
#pragma unroll
            for (int j = 0; j < 4; ++j) { v[j] = __builtin_nontemporal_load(xr + 64 * j); s += v[j][0] * v[j][0] + v[j][1] * v[j][1] + v[j][2] * v[j][2] + v[j][3] * v[j][3]; }
            s = wave_sum(s);
            u32x2* o = (u32x2*)((bf16*)(ws + WS_XB) + (size_t)t * D) + lane;
#pragma unroll
            for (int j = 0; j < 4; ++j) { u32x2 w; w.x = pk2(v[j][0], v[j][1]); w.y = pk2(v[j][2], v[j][3]); __builtin_nontemporal_store(w, o + 64 * j); }
            unsigned* o8 = (unsigned*)(ws + WS_XA + 32 * MiB + (size_t)t * D) + lane;
#pragma unroll
            for (int j = 0; j < 4; ++j) __builtin_nontemporal_store(pk4_fp8(v[j][0] * F8_XS, v[j][1] * F8_XS, v[j][2] * F8_XS, v[j][3] * F8_XS), o8 + 64 * j);
            if (lane == 0) ((float*)(ws + WS_RSTD0))[t] = __builtin_amdgcn_rsqf(s * (1.f / D) + EPS);
        }
    }
      } else {
    {
        const int gw = blockIdx.x * NWAVES + wave, NGW = G * NWAVES;
        const int r = lane & 15, kq = lane >> 4;
        for (int it = gw; it < 2 * 16 * 16 * 8; it += NGW) {
            const int kw = it & 7, dt = (it >> 3) & 15, hp = (it >> 7) & 15, l = it >> 11;
            const float* sk = P.in[21] + ((size_t)(l * 16 + hp) * 128 + kw * 16 + r) * 128 + 8 * kq;
            const float* wq = P.in[20] + ((size_t)l * 1024 + dt * 64 + r) * 2048 + hp * 128 + 8 * kq;
            f32x4 acc[4];
#pragma unroll
            for (int m = 0; m < 4; ++m) acc[m] = (f32x4){0.f, 0.f, 0.f, 0.f};
#pragma unroll
            for (int ks = 0; ks < 4; ++ks) {
                const f32x4 b0 = *(const f32x4*)(sk + ks * 32), b1 = *(const f32x4*)(sk + ks * 32 + 4);
                u32x4 bw; bw.x = pk2(b0[0], b0[1]); bw.y = pk2(b0[2], b0[3]); bw.z = pk2(b1[0], b1[1]); bw.w = pk2(b1[2], b1[3]);
#pragma unroll
                for (int m = 0; m < 4; ++m) {
                    const f32x4 a0 = *(const f32x4*)(wq + (size_t)m * 16 * 2048 + ks * 32), a1 = *(const f32x4*)(wq + (size_t)m * 16 * 2048 + ks * 32 + 4);
                    u32x4 aw; aw.x = pk2(a0[0], a0[1]); aw.y = pk2(a0[2], a0[3]); aw.z = pk2(a1[0], a1[1]); aw.w = pk2(a1[2], a1[3]);
                    acc[m] = __builtin_amdgcn_mfma_f32_16x16x32_bf16(__builtin_bit_cast(bf16x8, aw), __builtin_bit_cast(bf16x8, bw), acc[m], 0, 0, 0);
                }
            }
            unsigned char* o = ws + WS_WPQT + ((size_t)l * 2048 + hp * 128 + kw * 16 + r) * 1024 + dt * 64 + 4 * kq;
            const float* gf = P.in[3] + l * 1024 + dt * 64 + 4 * kq;
#pragma unroll
            for (int m = 0; m < 4; ++m) { const f32x4 gv = *(const f32x4*)(gf + m * 16);
                *(unsigned*)(o + m * 16) = pk4_i8(acc[m][0] * gv[0] * I8_WS, acc[m][1] * gv[1] * I8_WS, acc[m][2] * gv[2] * I8_WS, acc[m][3] * gv[3] * I8_WS); }
        }
    }
    {
        LAS float* scr = (LAS float*)(lds + wave * 16384);
        const int gw = blockIdx.x * NWAVES + wave, NGW = G * NWAVES;
        constexpr int I0 = 16 * 45, I1 = 6 * 24, I2 = 4 * 32, I3 = 16 * 32, I4 = 16 * 96, I5 = 16 * 32;
        for (int it = gw; it < I0 + I1 + I2 + I3 + I4 + I5; it += NGW) {
            int r = it;
            if (r < I0) { p0_transpose_item(P.in[4], P.in[2], 1024, 1440, (bf16*)(ws + WS_W0T), scr, r, lane, true, true); continue; } r -= I0;
            if (r < I1) { p0_transpose_item(P.in[7], P.in[6], 384, 768, (bf16*)(ws + WS_WUQT), scr, r, lane); continue; } r -= I1;
            if (r < I2) { p0_transpose_item(P.in[9], P.in[8], 256, 1024, (bf16*)(ws + WS_WUKVT), scr, r, lane); continue; } r -= I2;
            if (r < I3) { p0_transpose_item(P.in[5], nullptr, 1024, 1024, (bf16*)(ws + WS_WOUT0T), scr, r, lane, false, true); continue; } r -= I3;
            if (r < I4) { p0_transpose_item(P.in[15], P.in[2] + 1024, 1024, 3072, (bf16*)(ws + WS_W1T), scr, r, lane, false, true); continue; } r -= I4;
            p0_transpose_item(P.in[16], nullptr, 1024, 1024, (bf16*)(ws + WS_WOUT1T), scr, r, lane, false, true);
        }
    }
    { u32x4* z = (u32x4*)(ws + WS_W0T + (size_t)1440 * 1024); for (size_t i = gtid; i < (size_t)96 * 1024 / 16; i += gthreads) z[i] = (u32x4){0u, 0u, 0u, 0u}; }
      }
    }
    for (size_t i = gtid; i < 32768; i += gthreads) {
        const int pos = (int)(i >> 4), k = (int)(i & 15);
        const float inv = powf(10000.f, -(float)(2 * k) / 32.f), ang = (float)pos * inv;
        float sn, cs; sincosf(ang, &sn, &cs);
        ((float*)(ws + WS_ROPE))[pos * 16 + k] = cs; ((float*)(ws + WS_ROPE))[32768 + pos * 16 + k] = sn;
    }
    for (size_t i = gtid; i < 8 * 256; i += gthreads) {
        const int h = (int)(i >> 8), e = (int)(i & 255), rel = e - 191;
        const int n = rel < 0 ? -rel : rel;
        int large = 8 + (int)(logf((float)(n > 1 ? n : 1) / 8.f) / logf(16.f) * 8.f + 1e-3f); if (large > 15) large = 15;
        const int bucket = (rel > 0 ? 16 : 0) + (n < 8 ? n : large);
        ((float*)(ws + WS_T5TAB))[i] = P.in[1][bucket * 8 + h] * LOG2E;
    }
    for (size_t i = gtid; i < 16 * 320; i += gthreads) ((float*)(ws + WS_CATAB))[i] = P.in[19][i] * LOG2E;
    if (blockIdx.x == 0 && wave == 0) {
        const float* gqs[3] = {P.in[10], P.in[12], P.in[17]}; const float* gks[3] = {P.in[11], P.in[13], P.in[18]};
#pragma unroll
        for (int a = 0; a < 3; ++a) {
            const int nd = a == 0 ? 96 : 64;
            float mq = 0.f, mk = 0.f;
            for (int i = lane; i < nd; i += 64) { mq = fmaxf(mq, fabsf(gqs[a][i])); mk = fmaxf(mk, fabsf(gks[a][i])); }
#pragma unroll
            for (int o = 1; o < 64; o <<= 1) { mq = fmaxf(mq, __shfl_xor(mq, o)); mk = fmaxf(mk, __shfl_xor(mk, o)); }
            if (lane == 0) ((float*)(ws + WS_MQK))[a] = (float)nd * mq * mk * (a == 0 ? 0.10206207261596577f : 0.125f) * LOG2E * 1.02f;
        }
    }
}

template <int GL, bool ROPE>
__device__ __forceinline__ void norm_core(const bf16* src, bool active, const float (&g)[8], float inv_n, float prescale, const float* cs, int j, bf16* dst) {
    u32x4 w = (u32x4){0u, 0u, 0u, 0u};
    if (active) w = *(const u32x4*)src;
    float v[8] = {bflo(w.x), bfhi(w.x), bflo(w.y), bfhi(w.y), bflo(w.z), bfhi(w.z), bflo(w.w), bfhi(w.w)};
    float ss = 0.f;
#pragma unroll
    for (int i = 0; i < 8; ++i) ss += v[i] * v[i];
    ss += dpp_f<0xB1>(ss); ss += dpp_f<0x4E>(ss); ss += dpp_f<0x141>(ss);
    if (GL == 16) ss += dpp_f<0x140>(ss);
    const float r = __builtin_amdgcn_rsqf(ss * inv_n + EPS);
#pragma unroll
    for (int i = 0; i < 8; ++i) v[i] = v[i] * r * g[i];
    if (ROPE) {
        const int ci = ((j & 1) << 3);
        const bool isx1 = (j == 8 || j == 9), isx2 = (j == 10 || j == 11);
        const f32x4 c0 = *(const f32x4*)(cs + ci), c1 = *(const f32x4*)(cs + ci + 4), s0 = *(const f32x4*)(cs + 32768 + ci), s1 = *(const f32x4*)(cs + 32768 + ci + 4);
        const float cc[8] = {c0[0], c0[1], c0[2], c0[3], c1[0], c1[1], c1[2], c1[3]}, sn[8] = {s0[0], s0[1], s0[2], s0[3], s1[0], s1[1], s1[2], s1[3]};
#pragma unroll
        for (int i = 0; i < 8; ++i) {
            const int ln = (int)(threadIdx.x & 63u);
            const float up = __shfl(v[i], (ln + 2) & 63);
            const float dn = __shfl(v[i], (ln - 2) & 63);
            const float o1 = v[i] * cc[i] - up * sn[i], o2 = dn * sn[i] + v[i] * cc[i];
            v[i] = isx1 ? o1 : (isx2 ? o2 : v[i]);
        }
    }
    if (active) { u32x4 o; o.x = pk2(v[0] * prescale, v[1] * prescale); o.y = pk2(v[2] * prescale, v[3] * prescale); o.z = pk2(v[4] * prescale, v[5] * prescale); o.w = pk2(v[6] * prescale, v[7] * prescale);
        *(u32x4*)dst = o; }
}
__device__ __forceinline__ void load_gain8(const float* gain, int j, float (&g)[8]) { const f32x4 a = *(const f32x4*)(gain + 8 * j), b = *(const f32x4*)(gain + 8 * j + 4);
    g[0] = a[0]; g[1] = a[1]; g[2] = a[2]; g[3] = a[3]; g[4] = b[0]; g[5] = b[1]; g[6] = b[2]; g[7] = b[3]; }
__device__ __forceinline__ void vt_tile(LAS unsigned char* lds, const bf16* src, int pitch, int nh, int hstride, bf16* dst, int nh_total, int hd0, int b, int s0, int tid) {
    LAS bf16* Vl = (LAS bf16*)lds; const int VP = nh * 64 + 8;
    for (int id = tid; id < 64 * nh * 8; id += NTHR) { const int tok = id / (nh * 8), rem = id % (nh * 8), hd = rem >> 3, c = rem & 7;
        *(LAS u32x4*)(Vl + tok * VP + hd * 64 + c * 8) = *(const u32x4*)(src + (size_t)tok * pitch + hd * hstride + c * 8); }
    __syncthreads();
    for (int id = tid; id < nh * 64; id += NTHR) { const int hd = id >> 6, d = id & 63;
        bf16* o = dst + ((size_t)(b * nh_total + hd0 + hd) * 64 + d) * SEQ + s0;
#pragma unroll
        for (int grp = 0; grp < 4; ++grp) {
            unsigned w[8];
#pragma unroll
            for (int pp = 0; pp < 8; ++pp) { const int p0 = 2 * pp, p1 = 2 * pp + 1;
                const int k0 = 8 * ((p0 & 7) >> 2) + 4 * (p0 >> 3) + (p0 & 3), k1 = 8 * ((p1 & 7) >> 2) + 4 * (p1 >> 3) + (p1 & 3);
                w[pp] = (unsigned)Vl[(16 * grp + k0) * VP + hd * 64 + d] | ((unsigned)Vl[(16 * grp + k1) * VP + hd * 64 + d] << 16); }
            *(u32x4*)(o + 16 * grp) = (u32x4){w[0], w[1], w[2], w[3]}; *(u32x4*)(o + 16 * grp + 8) = (u32x4){w[4], w[5], w[6], w[7]};
        }
    }
    __syncthreads();
}

__device__ __forceinline__ void prep0_phase(const Ptrs& P, LAS unsigned char* lds, int tid, int lane, int wave) {
    unsigned char* ws = P.ws;
    const bf16* proj = (const bf16*)(ws + WS_BIG + BIG_PROJ); const bf16* qraw = (const bf16*)(ws + WS_BIG + BIG_QRAW); const bf16* kvraw = (const bf16*)(ws + WS_BIG + BIG_KVRAW);
    bf16* Qm = (bf16*)(ws + WS_ATT + ATT_QM); bf16* Km = (bf16*)(ws + WS_ATT + ATT_KM);
    bf16* SQ = (bf16*)(ws + WS_ATT + ATT_SQ); bf16* SK = (bf16*)(ws + WS_ATT + ATT_SK);
    const float* rope = (const float*)(ws + WS_ROPE);
    const int j16 = lane & 15, j8 = lane & 7; const bool act16 = j16 < 12; const int jc = act16 ? j16 : 11;
    float gq[8], gk[8], gsq[8], gsk[8];
    load_gain8(P.in[10], jc, gq); load_gain8(P.in[11], jc, gk); load_gain8(P.in[12], j8, gsq); load_gain8(P.in[13], j8, gsk);
    for (int tile = blockIdx.x; tile < T / 64; tile += gridDim.x) {
#pragma unroll 1
        for (int it = 0; it < 16; ++it) {
            const int vec = it * 32 + wave * 4 + (lane >> 4), tok = vec >> 3, hd = vec & 7, t = tile * 64 + tok, pos = t & (SEQ - 1);
            const float* cs = rope + pos * 16;
            norm_core<16, true>(qraw + (size_t)t * 768 + hd * 96 + jc * 8, act16, gq, 1.f / 96.f, 0.10206207261596577f * LOG2E, cs, j16, Qm + (size_t)t * 768 + hd * 96 + jc * 8);
            const bf16* ksrc = jc < 8 ? kvraw + (size_t)t * 1024 + hd * 128 + jc * 8 : proj + (size_t)t * 1536 + 640 + (jc - 8) * 8;
            norm_core<16, true>(ksrc, act16, gk, 1.f / 96.f, 1.f, cs, j16, Km + (size_t)t * 768 + hd * 96 + jc * 8);
        }
#pragma unroll 1
        for (int it = 0; it < 8; ++it) {
            const int vec = it * 64 + wave * 8 + (lane >> 3), tok = vec >> 3, hd = vec & 7, t = tile * 64 + tok;
            norm_core<8, false>(proj + (size_t)t * 1536 + 672 + hd * 64 + j8 * 8, true, gsq, 1.f / 64.f, 0.125f * LOG2E, nullptr, j8, SQ + (size_t)t * 512 + hd * 64 + j8 * 8);
        }
#pragma unroll 1
        for (int it = 0; it < 2; ++it) {
            const int vec = it * 64 + wave * 8 + (lane >> 3), tok = vec >> 1, hd = vec & 1, t = tile * 64 + tok;
            norm_core<8, false>(proj + (size_t)t * 1536 + 1184 + hd * 64 + j8 * 8, true, gsk, 1.f / 64.f, 1.f, nullptr, j8, SK + (size_t)t * 128 + hd * 64 + j8 * 8);
        }
    }
}
__device__ __forceinline__ void prep1_phase(const Ptrs& P, LAS unsigned char* lds, int tid, int lane, int wave) {
    unsigned char* ws = P.ws;
    const bf16* qkv = (const bf16*)(ws + WS_BIG);
    bf16* CQ = (bf16*)(ws + WS_ATT + ATT_CQ); bf16* CK = (bf16*)(ws + WS_ATT + ATT_CK);
    const int j8 = lane & 7;
    float gq[8], gk[8];
    load_gain8(P.in[17], j8, gq); load_gain8(P.in[18], j8, gk);
    for (int tile = blockIdx.x; tile < T / 64; tile += gridDim.x) {
#pragma unroll 1
        for (int it = 0; it < 16; ++it) {
            const int vec = it * 64 + wave * 8 + (lane >> 3), tok = vec >> 4, hd = vec & 15, t = tile * 64 + tok;
            norm_core<8, false>(qkv + (size_t)t * 3072 + hd * 64 + j8 * 8, true, gq, 1.f / 64.f, 0.125f * LOG2E, nullptr, j8, CQ + (size_t)t * 1024 + hd * 64 + j8 * 8);
            norm_core<8, false>(qkv + (size_t)t * 3072 + 1024 + hd * 64 + j8 * 8, true, gk, 1.f / 64.f, 1.f, nullptr, j8, CK + (size_t)t * 1024 + hd * 64 + j8 * 8);
        }
    }
}

constexpr int ATT_TABP = 400;
#define MFMA32(a, b, c) __builtin_amdgcn_mfma_f32_32x32x16_bf16((a), (b), (c), 0, 0, 0)
__device__ __forceinline__ constexpr int crow(int reg, int h) { return (reg & 3) + 8 * (reg >> 2) + 4 * h; }
template <int DQK, bool BIAS>
__device__ __forceinline__ void attn_tile(LAS unsigned char* Kl, LAS unsigned char* Vl, int cur, int kt, int w_lo, int w_hi, int lane, int r, int hh, const bf16x8 (&qf)[DQK / 16], f32x16& o0, f32x16& o1, float& l,
                                          float negM, const LAS float* btab, const LAS float* tpl, int const_from, int qchunk) {
    constexpr int NK = DQK / 16, KROW = DQK * 2 + 16, KBUF = 64 * KROW, VROW = 144, VBUF = 64 * VROW;
    if (kt >= w_lo && kt <= w_hi) {
            const LAS unsigned char* Kc = Kl + cur * KBUF + r * KROW + 16 * hh;
            const LAS unsigned char* Vc = Vl + cur * VBUF + (4 * hh + ((lane & 15) >> 2)) * VROW + (16 * ((lane >> 4) & 1) + 4 * (lane & 3)) * 2;
            f32x16 s0, s1;
            if (BIAS) {
                const LAS float* tp = (qchunk - kt >= const_from) ? btab : tpl + kt * 64;
#pragma unroll
                for (int g = 0; g < 4; ++g) { const f32x4 t0 = *(const LAS f32x4*)(tp + 8 * g), t1 = *(const LAS f32x4*)(tp + 32 + 8 * g);
#pragma unroll
                    for (int k = 0; k < 4; ++k) { s0[4 * g + k] = t0[k]; s1[4 * g + k] = t1[k]; } }
            } else {
#pragma unroll
                for (int i = 0; i < 16; ++i) { s0[i] = negM; s1[i] = negM; }
            }
#pragma unroll
            for (int ks = 0; ks < NK; ++ks) {
                const bf16x8 k0 = *(const LAS bf16x8*)(Kc + ks * 32), k1 = *(const LAS bf16x8*)(Kc + 32 * KROW + ks * 32);
                s0 = MFMA32(k0, qf[ks], s0); s1 = MFMA32(k1, qf[ks], s1);
            }
            float ps = 0.f;
#pragma unroll
            for (int i = 0; i < 16; ++i) { s0[i] = fexp2(s0[i]); s1[i] = fexp2(s1[i]); ps += s0[i] + s1[i]; }
            l += ps;
#pragma unroll
            for (int s2 = 0; s2 < 2; ++s2) {
                u32x4 pa, pb;
                pa.x = pk2(s0[8 * s2], s0[8 * s2 + 1]); pa.y = pk2(s0[8 * s2 + 2], s0[8 * s2 + 3]); pa.z = pk2(s0[8 * s2 + 4], s0[8 * s2 + 5]); pa.w = pk2(s0[8 * s2 + 6], s0[8 * s2 + 7]);
                pb.x = pk2(s1[8 * s2], s1[8 * s2 + 1]); pb.y = pk2(s1[8 * s2 + 2], s1[8 * s2 + 3]); pb.z = pk2(s1[8 * s2 + 4], s1[8 * s2 + 5]); pb.w = pk2(s1[8 * s2 + 6], s1[8 * s2 + 7]);
                const bf16x8 pfa = __builtin_bit_cast(bf16x8, pa), pfb = __builtin_bit_cast(bf16x8, pb);
#define TRV(keyoff, db) __builtin_shufflevector(__builtin_amdgcn_ds_read_tr16_b64_v4i16((LAS s16x4*)(Vc + (keyoff) * VROW + 64 * (db))), __builtin_amdgcn_ds_read_tr16_b64_v4i16((LAS s16x4*)(Vc + ((keyoff) + 8) * VROW + 64 * (db))), 0, 1, 2, 3, 4, 5, 6, 7)
                const bf16x8 va0 = TRV(s2 * 16, 0), va1 = TRV(s2 * 16, 1);
                const bf16x8 vb0 = TRV(32 + s2 * 16, 0), vb1 = TRV(32 + s2 * 16, 1);
#undef TRV
                o0 = MFMA32(va0, pfa, o0); o1 = MFMA32(va1, pfa, o1);
                o0 = MFMA32(vb0, pfb, o0); o1 = MFMA32(vb1, pfb, o1);
            }
        }
}
template <int NK> struct AttPre { u32x4 k0A, k1A, vA, k0B, k1B, vB; bf16x8 q[NK]; bool valid; };
struct AttNext { const bf16* Qw; const bf16* Kb; const bf16* Vb; int t_lo, t_hi; bool has; };
template <int DQK, bool BIAS, int QMODE, bool CHAIN = false>
__device__ __forceinline__ void attn_unit(LAS unsigned char* lds, int tid, int lane, const float* qgain, const float* qrope, const u64* qssq,
        const bf16* Qw, int qpitch, const bf16* Kb, int kpitch, const bf16* Vb, int vpitch,
        int t_lo, int t_hi, int w_lo, int w_hi, int qpos0, int qchunk,
        const LAS float* btab, int relmin, int const_from, float negM, float l_init, unsigned char* Ow, int opitch, AttPre<DQK / 16>& pre, const AttNext& nx) {
    constexpr int NK = DQK / 16, KROW = DQK * 2 + 16, CPR = DQK / 8, KCH = 64 * CPR, KBUF = 64 * KROW, VROW = 144, VBUF = 64 * VROW;
    LAS unsigned char* Kl = lds; LAS unsigned char* Vl = lds + 2 * KBUF;
    const int r = lane & 31, hh = lane >> 5;
    const int bq0 = relmin - (qpos0 + r) + 4 * hh + 64, sft = bq0 & 3; const LAS float* tpl = btab + sft * ATT_TABP + (bq0 - sft);
    const bool prel = CHAIN && pre.valid;
    bf16x8 qf[NK];
    if (prel) {
#pragma unroll
        for (int ks = 0; ks < NK; ++ks) qf[ks] = pre.q[ks];
    } else {
#pragma unroll
        for (int ks = 0; ks < NK; ++ks) qf[ks] = *(const bf16x8*)(Qw + (size_t)r * qpitch + ks * 16 + 8 * hh);
    }
    if (QMODE == 1) {
        float f[NK][8]; float ss = 0.f;
#pragma unroll
        for (int ks = 0; ks < NK; ++ks) { const u32x4 w = __builtin_bit_cast(u32x4, qf[ks]);
            f[ks][0] = bflo(w.x); f[ks][1] = bfhi(w.x); f[ks][2] = bflo(w.y); f[ks][3] = bfhi(w.y); f[ks][4] = bflo(w.z); f[ks][5] = bfhi(w.z); f[ks][6] = bflo(w.w); f[ks][7] = bfhi(w.w);
#pragma unroll
            for (int j = 0; j < 8; ++j) ss += f[ks][j] * f[ks][j]; }
        ss += __shfl_xor(ss, 32);
        const float rn = __builtin_amdgcn_rsqf(ss * (1.f / DQK) + EPS * (ssq_get(qssq + r) * (1.f / 384.f) + EPS));
#pragma unroll
        for (int ks = 0; ks < NK; ++ks) { const f32x4 g0 = *(const f32x4*)(qgain + ks * 16 + 8 * hh), g1 = *(const f32x4*)(qgain + ks * 16 + 8 * hh + 4);
#pragma unroll
            for (int j = 0; j < 4; ++j) { f[ks][j] *= rn * g0[j]; f[ks][4 + j] *= rn * g1[j]; } }
        { const float* cs = qrope + (qpos0 + r) * 16 + 8 * hh;
          const f32x4 c0 = *(const f32x4*)cs, c1 = *(const f32x4*)(cs + 4), s0 = *(const f32x4*)(cs + 32768), s1 = *(const f32x4*)(cs + 32768 + 4);
#pragma unroll
          for (int j = 0; j < 8; ++j) { const float c = j < 4 ? c0[j & 3] : c1[j & 3], sn = j < 4 ? s0[j & 3] : s1[j & 3], x1 = f[4][j], x2 = f[5][j]; f[4][j] = x1 * c - x2 * sn; f[5][j] = x1 * sn + x2 * c; } }
        const float psc = 0.10206207261596577f * LOG2E;
#pragma unroll
        for (int ks = 0; ks < NK; ++ks) { u32x4 w; w.x = pk2(f[ks][0] * psc, f[ks][1] * psc); w.y = pk2(f[ks][2] * psc, f[ks][3] * psc); w.z = pk2(f[ks][4] * psc, f[ks][5] * psc); w.w = pk2(f[ks][6] * psc, f[ks][7] * psc);
            qf[ks] = __builtin_bit_cast(bf16x8, w); }
    }
    f32x16 o0, o1;
#pragma unroll
    for (int i = 0; i < 16; ++i) { o0[i] = 0.f; o1[i] = 0.f; }
    float l = hh == 0 ? l_init : 0.f;
    const int kc1 = tid + NTHR; const bool k1v = kc1 < KCH;
    const int kr0 = tid / CPR, kcc0 = tid % CPR, kr1 = kc1 / CPR, kcc1 = kc1 % CPR, vr = tid >> 3, vc = tid & 7;
    u32x4 lk0A, lk1A = (u32x4){0u, 0u, 0u, 0u}, lvA, lk0B, lk1B = (u32x4){0u, 0u, 0u, 0u}, lvB;
    u32x4 &kreg0A = CHAIN ? pre.k0A : lk0A, &kreg1A = CHAIN ? pre.k1A : lk1A, &vregA = CHAIN ? pre.vA : lvA, &kreg0B = CHAIN ? pre.k0B : lk0B, &kreg1B = CHAIN ? pre.k1B : lk1B, &vregB = CHAIN ? pre.vB : lvB;
#define ATT_LOADS(S, kt) do { kreg0##S = *(const u32x4*)(Kb + (size_t)((kt) * 64 + kr0) * kpitch + kcc0 * 8); if (k1v) kreg1##S = *(const u32x4*)(Kb + (size_t)((kt) * 64 + kr1) * kpitch + kcc1 * 8); \
        vreg##S = *(const u32x4*)(Vb + (size_t)((kt) * 64 + vr) * vpitch + vc * 8); } while (0)
#define ATT_STORES(S, buf) do { *(LAS u32x4*)(Kl + (buf) * KBUF + kr0 * KROW + kcc0 * 16) = kreg0##S; if (k1v) *(LAS u32x4*)(Kl + (buf) * KBUF + kr1 * KROW + kcc1 * 16) = kreg1##S; \
        *(LAS u32x4*)(Vl + (buf) * VBUF + vr * VROW + vc * 16) = vreg##S; } while (0)
#define ATT_BAR() do { asm volatile("s_waitcnt lgkmcnt(0)" ::: "memory"); __builtin_amdgcn_s_barrier(); asm volatile("" ::: "memory"); } while (0)
#define ATT_NEXT(S, kt) do { kreg0##S = *(const u32x4*)(nx.Kb + (size_t)((kt) * 64 + kr0) * kpitch + kcc0 * 8); if (k1v) kreg1##S = *(const u32x4*)(nx.Kb + (size_t)((kt) * 64 + kr1) * kpitch + kcc1 * 8); \
        vreg##S = *(const u32x4*)(nx.Vb + (size_t)((kt) * 64 + vr) * vpitch + vc * 8); } while (0)
#define ATT_NEXTQ() do { _Pragma("unroll") for (int _ks = 0; _ks < NK; ++_ks) pre.q[_ks] = *(const bf16x8*)(nx.Qw + (size_t)r * qpitch + _ks * 16 + 8 * hh); } while (0)
    const bool chain = CHAIN && nx.has;
    bool doneA = !chain, doneB = !chain || (nx.t_lo + 1 > nx.t_hi);
    if (!prel) ATT_LOADS(A, t_lo);
    ATT_STORES(A, 0);
    if (!prel && t_lo + 1 <= t_hi) ATT_LOADS(B, t_lo + 1);
    ATT_BAR();
    for (int kt0 = t_lo; kt0 <= t_hi; kt0 += 2) {
        if (kt0 + 2 <= t_hi) ATT_LOADS(A, kt0 + 2);
        else if (!doneA) { ATT_NEXT(A, nx.t_lo); doneA = true; }
        attn_tile<DQK, BIAS>(Kl, Vl, 0, kt0, w_lo, w_hi, lane, r, hh, qf, o0, o1, l, negM, btab, tpl, const_from, qchunk);
        if (kt0 + 1 <= t_hi) ATT_STORES(B, 1);
        ATT_BAR();
        if (kt0 + 1 > t_hi) break;
        if (kt0 + 3 <= t_hi) ATT_LOADS(B, kt0 + 3);
        else if (!doneB) { ATT_NEXT(B, nx.t_lo + 1); doneB = true; }
        attn_tile<DQK, BIAS>(Kl, Vl, 1, kt0 + 1, w_lo, w_hi, lane, r, hh, qf, o0, o1, l, negM, btab, tpl, const_from, qchunk);
        if (kt0 + 2 <= t_hi) ATT_STORES(A, 0);
        ATT_BAR();
    }
    if (!doneA) { ATT_NEXT(A, nx.t_lo); }
    if (!doneB) { ATT_NEXT(B, nx.t_lo + 1); }
    if (chain) ATT_NEXTQ();
    if (CHAIN) pre.valid = chain;
#undef ATT_LOADS
#undef ATT_STORES
#undef ATT_NEXT
#undef ATT_NEXTQ

    const float lt = l + __shfl_xor(l, 32), inv = F8_XS / lt;
    unsigned wa[4], wb[4];
#pragma unroll
    for (int g = 0; g < 4; ++g) {
        wa[g] = pk4_fp8(o0[4 * g] * inv, o0[4 * g + 1] * inv, o0[4 * g + 2] * inv, o0[4 * g + 3] * inv);
        wb[g] = pk4_fp8(o1[4 * g] * inv, o1[4 * g + 1] * inv, o1[4 * g + 2] * inv, o1[4 * g + 3] * inv);
        const u32x2 sw = __builtin_amdgcn_permlane32_swap(wa[g], wb[g], false, false);
        wa[g] = sw.x; wb[g] = sw.y;
    }
    unsigned char* orow = Ow + (size_t)r * opitch + 32 * hh;
    *(u32x4*)orow = (u32x4){wa[0], wb[0], wa[1], wb[1]};
    *(u32x4*)(orow + 16) = (u32x4){wa[2], wb[2], wa[3], wb[3]};
}
constexpr int ATT_TAB_OFF = 2 * 64 * 208 + 2 * 64 * 144;

template <int NI>
__device__ __forceinline__ void fill_bias_images(LAS float* btab, const float (&tv)[NI], float M, int lane) {
    constexpr int n = NI * 64;
    const float t0 = __builtin_bit_cast(float, __builtin_amdgcn_readlane(__builtin_bit_cast(int, tv[0]), 0)) - M;
    const float tl = __builtin_bit_cast(float, __builtin_amdgcn_readlane(__builtin_bit_cast(int, tv[NI - 1]), 63)) - M;
#pragma unroll
    for (int sh = 0; sh < 4; ++sh) {
        LAS float* cp = btab + sh * ATT_TABP;
        cp[lane] = t0;
#pragma unroll
        for (int i = 0; i < NI; ++i) cp[lane + 64 * i + 64 - sh] = tv[i] - M;
        if (n + 64 - sh + lane < ATT_TABP) cp[n + 64 - sh + lane] = tl;
    }
}
__device__ __forceinline__ void attn0_phase(const Ptrs& P, LAS unsigned char* lds, int tid, int lane, int wave) {
    unsigned char* ws = P.ws;
    const bf16* qraw = (const bf16*)(ws + WS_BIG + BIG_QRAW); const bf16* Km = (const bf16*)(ws + WS_ATT + ATT_KM); const bf16* Vm = (const bf16*)(ws + WS_ATT + ATT_VMT);
    const bf16* proj = (const bf16*)(ws + WS_BIG + BIG_PROJ);
    unsigned char* mix = ws + WS_MIX;
    LAS float* btab = (LAS float*)(lds + ATT_TAB_OFF) + wave * (4 * ATT_TABP);
    const float Mmla = ((const float*)(ws + WS_MQK))[0], Mswa = ((const float*)(ws + WS_MQK))[1];
    const AttNext nonext{nullptr, nullptr, nullptr, 0, 0, false};
    for (int pi = blockIdx.x; pi < 256; pi += gridDim.x) {
        const int bh = pi & 63, qb0 = pi >> 6, b = bh >> 3, hd = bh & 7;
#pragma unroll 1
        for (int rep = 0; rep < 2; ++rep) {
            const int qb = rep ? 7 - qb0 : qb0, cw = 4 * qb + (wave >> 1), qpos0 = cw * 64 + 32 * (wave & 1);
            AttPre<6> pre96; pre96.valid = false;
            attn_unit<96, false, 1>(lds, tid, lane, P.in[10], (const float*)(ws + WS_ROPE), (const u64*)(ws + CTL_SSQ_CQ) + b * SEQ + qpos0, qraw + (size_t)(b * SEQ + qpos0) * 768 + hd * 96, 768, Km + (size_t)b * SEQ * 768 + hd * 96, 768, Vm + (size_t)b * SEQ * 512 + hd * 64, 512,
                0, 4 * qb + 3, 0, cw, qpos0, cw, btab, 0, 0, -Mmla, 0.f, mix + (size_t)(b * SEQ + qpos0) * 1024 + hd * 64, 1024, pre96, nonext);
        }
    }
    int swa_head = -1; float Msw = 0.f;
    AttPre<4> pre64; pre64.valid = false;
    for (int u = blockIdx.x; u < 512; u += gridDim.x) {
        const int b = u >> 6, kvh = (u >> 5) & 1, c = u & 31, head = kvh * 4 + (wave >> 1), qpos0 = c * 64 + 32 * (wave & 1);
        if (head != swa_head) {
            swa_head = head;
            const float* tab = (const float*)(ws + WS_T5TAB) + head * 256;
            float bmax = -1e30f;
            float tv[4];
#pragma unroll
            for (int i = 0; i < 4; ++i) { tv[i] = tab[lane + 64 * i]; if (lane + 64 * i < 255) bmax = fmaxf(bmax, tv[i]); }
#pragma unroll
            for (int o = 1; o < 64; o <<= 1) bmax = fmaxf(bmax, __shfl_xor(bmax, o));
            Msw = Mswa + fmaxf(bmax, 0.f);
            fill_bias_images<4>(btab, tv, Msw, lane);
            LDS_WAIT();
        }
        const float sinkl = P.in[14][head] * LOG2E;
        const int tlo = c >= 2 ? c - 2 : 0;
        AttNext nx; { const int un = u + (int)gridDim.x; nx.has = un < 512;
            const int bn = un >> 6, kvhn = (un >> 5) & 1, cn = un & 31, headn = kvhn * 4 + (wave >> 1), qposn = cn * 64 + 32 * (wave & 1);
            nx.Qw = proj + (size_t)(bn * SEQ + qposn) * 1536 + 640 + headn * 64; nx.Kb = proj + (size_t)bn * SEQ * 1536 + 1152 + kvhn * 64; nx.Vb = proj + (size_t)bn * SEQ * 1536 + 1280 + kvhn * 64;
            nx.t_lo = cn >= 2 ? cn - 2 : 0; nx.t_hi = cn; }
        attn_unit<64, true, 0, true>(lds, tid, lane, nullptr, nullptr, nullptr, proj + (size_t)(b * SEQ + qpos0) * 1536 + 640 + head * 64, 1536, proj + (size_t)b * SEQ * 1536 + 1152 + kvh * 64, 1536, proj + (size_t)b * SEQ * 1536 + 1280 + kvh * 64, 1536,
            tlo, c, tlo, c, qpos0, c, btab, 191, 1000, -Msw, fexp2(sinkl - Msw), mix + (size_t)(b * SEQ + qpos0) * 1024 + 512 + head * 64, 1024, pre64, nx);
    }
}
__device__ __forceinline__ void attn1_phase(const Ptrs& P, LAS unsigned char* lds, int tid, int lane, int wave) {
    unsigned char* ws = P.ws;
    const bf16* CQ = (const bf16*)(ws + WS_ATT + ATT_CQ); const bf16* CK = (const bf16*)(ws + WS_ATT + ATT_CK); const bf16* CV = (const bf16*)(ws + WS_ATT + ATT_CVT);
    unsigned char* mix = ws + WS_MIX;
    LAS float* btab = (LAS float*)(lds + ATT_TAB_OFF) + wave * (4 * ATT_TABP);
    int ca_head = -1; float Mc = 0.f;
    AttPre<4> pre64; pre64.valid = false;
    for (int u = blockIdx.x; u < 1024; u += gridDim.x) {
        const int qb = (u >> 7) & 7, bh = u & 127, b = bh >> 4, hd = bh & 15, cw = 4 * qb + (wave >> 1), qpos0 = cw * 64 + 32 * (wave & 1);
        if (hd != ca_head) {
            ca_head = hd;
            const float* tab = (const float*)(ws + WS_CATAB) + hd * 320;
            float bmax = -1e30f;
            float tv[5];
#pragma unroll
            for (int i = 0; i < 5; ++i) { tv[i] = tab[lane + 64 * i]; bmax = fmaxf(bmax, tv[i]); }
#pragma unroll
            for (int o = 1; o < 64; o <<= 1) bmax = fmaxf(bmax, __shfl_xor(bmax, o));
            Mc = ((const float*)(ws + WS_MQK))[2] + fmaxf(bmax, 0.f);
            fill_bias_images<5>(btab, tv, Mc, lane);
            LDS_WAIT();
        }
        const int tlo = 4 * qb >= 8 ? 4 * qb - 8 : 0, wlo = cw >= 8 ? cw - 8 : 0;
        AttNext nx; { const int un = u + (int)gridDim.x; nx.has = un < 1024;
            const int qbn = (un >> 7) & 7, bhn = un & 127, bn = bhn >> 4, hdn = bhn & 15, cwn = 4 * qbn + (wave >> 1), qposn = cwn * 64 + 32 * (wave & 1);
            nx.Qw = CQ + (size_t)(bn * SEQ + qposn) * 1024 + hdn * 64; nx.Kb = CK + (size_t)bn * SEQ * 1024 + hdn * 64; nx.Vb = CV + (size_t)bn * SEQ * 1024 + hdn * 64;
            nx.t_lo = 4 * qbn >= 8 ? 4 * qbn - 8 : 0; nx.t_hi = 4 * qbn + 3; }
        attn_unit<64, true, 0, true>(lds, tid, lane, nullptr, nullptr, nullptr, CQ + (size_t)(b * SEQ + qpos0) * 1024 + hd * 64, 1024, CK + (size_t)b * SEQ * 1024 + hd * 64, 1024, CV + (size_t)b * SEQ * 1024 + hd * 64, 1024,
            tlo, 4 * qb + 3, wlo, cw, qpos0, cw, btab, 256, 5, -Mc, 0.f, mix + (size_t)(b * SEQ + qpos0) * 1024 + hd * 64, 1024, pre64, nx);
    }
}

__device__ __forceinline__ int sortable(float f) { const int b = __builtin_bit_cast(int, f); return b ^ ((b >> 31) & 0x7fffffff); }
__device__ __forceinline__ float unsortable(int k) { return __builtin_bit_cast(float, k ^ ((k >> 31) & 0x7fffffff)); }
#define INS16(s, x) do { int _x = (x); _Pragma("unroll") for (int _i = 0; _i < 16; ++_i) { const int _hi = max(s[_i], _x); _x = min(s[_i], _x); s[_i] = _hi; } } while (0)
#define CE(v, a, b) { const int _h = max(v[a], v[b]); v[b] = min(v[a], v[b]); v[a] = _h; }
#define SORT16(v) do { CE(v,0,1) CE(v,2,3) CE(v,0,2) CE(v,1,3) CE(v,1,2) CE(v,4,5) CE(v,6,7) CE(v,4,6) CE(v,5,7) CE(v,5,6) CE(v,0,4) CE(v,2,6) CE(v,2,4) CE(v,1,5) CE(v,3,7) CE(v,3,5) CE(v,1,2) CE(v,3,4) CE(v,5,6) CE(v,8,9) CE(v,10,11) CE(v,8,10) CE(v,9,11) CE(v,9,10) CE(v,12,13) CE(v,14,15) CE(v,12,14) CE(v,13,15) CE(v,13,14) CE(v,8,12) CE(v,10,14) CE(v,10,12) CE(v,9,13) CE(v,11,15) CE(v,11,13) CE(v,9,10) CE(v,11,12) CE(v,13,14) CE(v,0,8) CE(v,4,12) CE(v,4,8) CE(v,2,10) CE(v,6,14) CE(v,6,10) CE(v,2,4) CE(v,6,8) CE(v,10,12) CE(v,1,9) CE(v,5,13) CE(v,5,9) CE(v,3,11) CE(v,7,15) CE(v,7,11) CE(v,3,5) CE(v,7,9) CE(v,11,13) CE(v,1,2) CE(v,3,4) CE(v,5,6) CE(v,7,8) CE(v,9,10) CE(v,11,12) CE(v,13,14) } while (0)
#define BMERGE16(v) do { CE(v,0,8) CE(v,1,9) CE(v,2,10) CE(v,3,11) CE(v,4,12) CE(v,5,13) CE(v,6,14) CE(v,7,15) CE(v,0,4) CE(v,1,5) CE(v,2,6) CE(v,3,7) CE(v,8,12) CE(v,9,13) CE(v,10,14) CE(v,11,15) CE(v,0,2) CE(v,1,3) CE(v,4,6) CE(v,5,7) CE(v,8,10) CE(v,9,11) CE(v,12,14) CE(v,13,15) CE(v,0,1) CE(v,2,3) CE(v,4,5) CE(v,6,7) CE(v,8,9) CE(v,10,11) CE(v,12,13) CE(v,14,15) } while (0)

#define MERGE_TOP16(R, S) do { _Pragma("unroll") for (int _i = 0; _i < 16; ++_i) R[_i] = max(R[_i], S[15 - _i]); BMERGE16(R); } while (0)
__device__ __forceinline__ int key_of(unsigned bits, int idx) { const int b = (int)bits; return ((b ^ ((b >> 31) & 0x7fffffff)) & ~127) | (127 - idx); }
#define TK_LOAD(dst, q) do { const u32x4 _a = __builtin_nontemporal_load((const u32x4*)(q)), _b = __builtin_nontemporal_load((const u32x4*)((q) + 256)); dst[0] = _a.x; dst[1] = _a.y; dst[2] = _a.z; dst[3] = _a.w; dst[4] = _b.x; dst[5] = _b.y; dst[6] = _b.z; dst[7] = _b.w; } while (0)
#define TK_KEYS(K, src, k0) do { _Pragma("unroll") for (int _j = 0; _j < 8; ++_j) { K[2 * _j] = (int)((src[_j] << 16) | (unsigned)(127 - ((k0) + 2 * _j))); K[2 * _j + 1] = (int)((src[_j] & 0xffff0000u) | (unsigned)(127 - ((k0) + 2 * _j + 1))); } } while (0)
__device__ __forceinline__ void top16_both(const unsigned* p, int (&R1)[16], int (&R2)[16]) {
    unsigned w[8], wn[8];
    TK_LOAD(w, p);
    TK_LOAD(wn, p + (size_t)8 * 64);
    TK_KEYS(R1, w, 0); SORT16(R1);
#pragma unroll
    for (int j = 0; j < 8; ++j) w[j] = wn[j];
#pragma unroll 1
    for (int c = 1; c < 8; ++c) {
        const unsigned* q = c < 7 ? p + (size_t)(c + 1) * 8 * 64 : p + (size_t)64 * 64;
        TK_LOAD(wn, q);
        int S[16]; TK_KEYS(S, w, c * 16); SORT16(S); MERGE_TOP16(R1, S);
#pragma unroll
        for (int j = 0; j < 8; ++j) w[j] = wn[j];
    }
    const unsigned* p2 = p + (size_t)64 * 64;
    TK_LOAD(wn, p2 + (size_t)8 * 64);
    TK_KEYS(R2, w, 0); SORT16(R2);
#pragma unroll
    for (int j = 0; j < 8; ++j) w[j] = wn[j];
#pragma unroll 1
    for (int c = 1; c < 8; ++c) {
        if (c < 7) TK_LOAD(wn, p2 + (size_t)(c + 1) * 8 * 64);
        int S[16]; TK_KEYS(S, w, c * 16); SORT16(S); MERGE_TOP16(R2, S);
#pragma unroll
        for (int j = 0; j < 8; ++j) w[j] = wn[j];
    }
}
#undef TK_LOAD
#undef TK_KEYS
__device__ __forceinline__ void gatherU_phase(LAS unsigned char* lds, const bf16* xin, const u64* ssq, const float* gffn, const unsigned char* Us, const unsigned* poff, const float* pw,
                                              unsigned* pka, float* asc, float mul, int grp, const int nw, const int ge, int lane, int wave);
__device__ __forceinline__ void topk_phase(const Ptrs& P, LAS unsigned char* lds, int tid, int lane, int wave, const bf16* xin, const u64* ssq, const float* gffn, const unsigned char* Us, float mul) {
    unsigned char* ws = P.ws;
    const unsigned* scT = (const unsigned*)(ws + WS_BIG);
    unsigned* poff = (unsigned*)(ws + WS_EIDX); float* pw = (float*)(ws + WS_PW);
    LAS int* idxL = (LAS int*)lds; LAS float* wL = (LAS float*)(lds + 64 * 129 * 4);
    for (int g = blockIdx.x; g < T / 64; g += gridDim.x) {
        const unsigned* base = scT + (((size_t)g * 256 + wave * 32) * 64 + lane) * 4;
        int s1[16], s2[16];
        top16_both(base, s1, s2);
        float f1[16], f2[16];
#pragma unroll
        for (int i = 0; i < 16; ++i) { const int k1 = s1[i] & (int)0xffff0000, k2 = s2[i] & (int)0xffff0000; f1[i] = __builtin_bit_cast(float, k1 ^ ((k1 >> 31) & 0x7fff0000)); f2[i] = __builtin_bit_cast(float, k2 ^ ((k2 >> 31) & 0x7fff0000)); }
        int th[16], ga[16], gb[16];
#pragma unroll
        for (int b = 0; b < 16; ++b) th[b] = sortable(f1[0] + f2[b]);
        {
            int n = 0;
#pragma unroll
            for (int a = 1; a < 16; ++a)
#pragma unroll
                for (int b = 0; b < 16 / (a + 1); ++b) { const int x = sortable(f1[a] + f2[b]); if (n < 16) ga[n] = x; else if (n < 32) gb[n - 16] = x; ++n; }
        }
        SORT16(ga); MERGE_TOP16(th, ga); SORT16(gb); MERGE_TOP16(th, gb);
        { const int x14 = sortable(f1[14] + f2[0]), x15 = sortable(f1[15] + f2[0]); INS16(th, x14); INS16(th, x15); }
        const int tau = th[15]; const float cmax = f1[0] + f2[0];
        int cnt = 0; float sum = 0.f; int ngt = 0;
        const int rowo = lane * 129 + wave * 16;
#pragma unroll
        for (int a = 0; a < 16; ++a)
#pragma unroll
            for (int b = 0; b < 16 / (a + 1); ++b) ngt += sortable(f1[a] + f2[b]) > tau ? 1 : 0;
        int eq_left = 16 - ngt;
#pragma unroll
        for (int a = 0; a < 16; ++a)
#pragma unroll
            for (int b = 0; b < 16 / (a + 1); ++b) {
                const float c = f1[a] + f2[b]; const int xs = sortable(c);
                const bool iseq = xs == tau;
                if (xs > tau || (iseq && eq_left > 0)) {
                    eq_left -= iseq ? 1 : 0;
                    const float w = fexp2((c - cmax) * LOG2E); sum += w;
                    idxL[rowo + cnt] = ((127 - (s1[a] & 127)) << 7) | (127 - (s2[b] & 127)); wL[rowo + cnt] = w; ++cnt;
                }
            }
        const float inv = 1.f / sum;
#pragma unroll
        for (int i = 0; i < 16; ++i) wL[rowo + i] *= inv;
        __syncthreads();
#pragma unroll
        for (int i = 0; i < 16; ++i) { const int flat = i * NTHR + tid, tok = flat >> 7, k = flat & 127;
            poff[(size_t)(g * 64 + tok) * 128 + k] = (unsigned)idxL[tok * 129 + k] << 7; pw[(size_t)(g * 64 + tok) * 128 + k] = wL[tok * 129 + k]; }
        __syncthreads();
        gatherU_phase(lds, xin, ssq, gffn, Us, poff, pw, (unsigned*)(ws + WS_PKA), (float*)(ws + WS_EW), mul, g * 8 + wave, 1 << 28, g * 8 + 8, lane, wave);
        __syncthreads();
    }
}

struct XcdPart { int wr, nw, s0, ns; };
#define G8_LOADS(ur, base, oL, bufo, blk) do { _Pragma("unroll") for (int _q = 0; _q < 2; ++_q) { const u32x4 _o = *(const LAS u32x4*)((oL) + (bufo) + g * 128 + (blk) * 8 + 4 * _q); \
        _Pragma("unroll") for (int _j = 0; _j < 4; ++_j) ur[4 * _q + _j] = *(const u32x4*)((base) + (size_t)(_o[_j] | c16)); } } while (0)
#define G8_SCHED() __builtin_amdgcn_sched_barrier(0)
__device__ __forceinline__ int dpp_i(int v, int) { return v; }
template <int CTRL> __device__ __forceinline__ int dpp_iadd(int v) { return v + __builtin_amdgcn_update_dpp(0, v, CTRL, 0xf, 0xf, true); }
__device__ __forceinline__ void gatherU_phase(LAS unsigned char* lds, const bf16* xin, const u64* ssq, const float* gffn, const unsigned char* Us, const unsigned* poff, const float* pw,
                                              unsigned* pka, float* asc, float mul, int grp, const int nw, const int ge, int lane, int wave) {
    const int g = lane >> 3, c = lane & 7; const unsigned c16 = (unsigned)c * 16u;
    LAS float* accL = (LAS float*)(lds + wave * 16384);
    LAS unsigned* xL = (LAS unsigned*)(lds + wave * 16384 + 4096);
    LAS unsigned* oL = (LAS unsigned*)(lds + wave * 16384 + 8192);
    if (grp >= ge) return;
    int s4 = 0;
    u32x4 oq[4], xpre[4]; u64 spre = 0; int snext = 0; u32x4 urA[8], urB[8]; int hqh[4], hql[4]; float deq = 0.f, deqn = 0.f;
#define GU_LOADA(gg, ss) do { _Pragma("unroll") for (int _q = 0; _q < 4; ++_q) { oq[_q] = *(const u32x4*)(poff + (size_t)(gg) * 1024 + 256 * _q + 4 * lane); \
            xpre[_q] = *(const u32x4*)(xin + (size_t)((gg) * 8 + g) * D + 256 * (ss) + 8 * c + 64 * _q); } spre = ssq[(gg) * 8 + g]; snext = (ss); } while (0)
#define GU_WRITEA(bufo) do { _Pragma("unroll") for (int _q = 0; _q < 4; ++_q) *(LAS u32x4*)(oL + (bufo) + 256 * _q + 4 * lane) = oq[_q]; \
            const float* gfs = gffn + 256 * snext + 32 * c; \
            const float _rs = __builtin_amdgcn_rsqf((float)spre * 2.3283064365386963e-10f * (1.f / D) + EPS); \
            float _h[32]; float _mx = 1e-20f; \
            _Pragma("unroll") for (int _q = 0; _q < 4; ++_q) *(LAS u32x4*)(xL + g * 128 + 4 * (8 * _q + c)) = xpre[_q]; \
            asm volatile("" ::: "memory");     \
            _Pragma("unroll") for (int _q = 0; _q < 4; ++_q) { const f32x4 _g0 = *(const f32x4*)(gfs + 8 * _q), _g1 = *(const f32x4*)(gfs + 8 * _q + 4); const u32x4 _xw = *(const LAS u32x4*)(xL + g * 128 + 16 * c + 4 * _q); \
                _Pragma("unroll") for (int _j = 0; _j < 4; ++_j) { const float _ga = _j < 2 ? _g0[2 * (_j & 1)] : _g1[2 * (_j & 1)], _gb = _j < 2 ? _g0[2 * (_j & 1) + 1] : _g1[2 * (_j & 1) + 1]; \
                    _h[8 * _q + 2 * _j] = bflo(_xw[_j]) * _rs * _ga; _h[8 * _q + 2 * _j + 1] = bfhi(_xw[_j]) * _rs * _gb; _mx = fmaxf(_mx, fmaxf(fabsf(_h[8 * _q + 2 * _j]), fabsf(_h[8 * _q + 2 * _j + 1]))); } } \
            const float _sh = 7.f * __builtin_amdgcn_rcpf(_mx); deqn = _mx * (1.f / (7.f * 96.f));        \
            _Pragma("unroll") for (int _q = 0; _q < 4; ++_q) { unsigned _wh = 0u; _Pragma("unroll") for (int _j = 0; _j < 8; ++_j) { const int _qi = (int)__builtin_rintf(_h[8 * _q + _j] * _sh); \
                _wh |= ((unsigned)_qi & 0xfu) << (4 * _j); } hqh[_q] = (int)_wh; hql[_q] = 0; } } while (0)
#define GU_COMPUTE(ur, blk) do { float _r = 0.f; _Pragma("unroll") for (int _i = 0; _i < 8; ++_i) { int _di = 0; \
            _Pragma("unroll") for (int _j = 0; _j < 4; ++_j) { _di = __builtin_amdgcn_sdot8((int)ur[_i][_j], hqh[_j], _di, false); } \
            float _d = (float)_di * deq; _d += dpp_f<0xB1>(_d); _d += dpp_f<0x4E>(_d); _d += dpp_f<0x141>(_d); \
            _r = (c == _i) ? _d : _r; } \
            LAS float* _ap = accL + g * 128 + 8 * (blk) + c; *_ap = s4 ? *_ap + _r : _r; } while (0)
    GU_LOADA(grp, 0); GU_WRITEA(0); deq = deqn;
    int bufo = 0;
    const unsigned char* Ub = Us;
    G8_LOADS(urA, Ub, oL, bufo, 0);
    for (;;) {
        int ns4 = s4 + 1, ngrp = grp; if (ns4 == 4) { ns4 = 0; ngrp = grp + nw; }
        const bool has = ngrp < ge;
        const unsigned char* Un = Us + (size_t)ns4 * 16384 * 128;
        if (has) GU_LOADA(ngrp, ns4);
#pragma unroll 1
        for (int bp = 0; bp < 8; ++bp) {
            G8_LOADS(urB, Ub, oL, bufo, 2 * bp + 1); G8_SCHED();
            GU_COMPUTE(urA, 2 * bp); G8_SCHED();
            if (bp < 7) { G8_LOADS(urA, Ub, oL, bufo, 2 * bp + 2); G8_SCHED(); GU_COMPUTE(urB, 2 * bp + 1); }
            else {
                GU_COMPUTE(urB, 2 * bp + 1); G8_SCHED();
                if (has) { GU_WRITEA(bufo ^ 1024); G8_LOADS(urA, Un, oL, bufo ^ 1024, 0); }
            }
            G8_SCHED();
        }
        if (s4 == 3) {
            G8_SCHED(); asm volatile("" ::: "memory");
#pragma unroll
            for (int q = 0; q < 4; ++q) {
                const u32x4 po = *(const LAS u32x4*)(oL + bufo + 256 * q + 4 * lane);
                const f32x4 wv = *(const f32x4*)(pw + (size_t)grp * 1024 + 256 * q + 4 * lane);
                const f32x4 dq = *(const LAS f32x4*)(accL + 256 * q + 4 * lane);
                f32x4 av; float mx = 0.f;
#pragma unroll
                for (int j = 0; j < 4; ++j) { av[j] = gelu_tanh(dq[j]) * wv[j] * mul; mx = fmaxf(mx, fabsf(av[j])); }
                mx = fmaxf(mx, dpp_f<0xB1>(mx)); mx = fmaxf(mx, dpp_f<0x4E>(mx)); mx = fmaxf(mx, dpp_f<0x141>(mx)); mx = fmaxf(mx, dpp_f<0x140>(mx)); mx = fmaxf(mx, __shfl_xor(mx, 16));
                mx = fmaxf(mx, 1e-30f);
                const float qs = 127.f * __builtin_amdgcn_rcpf(mx);
                u32x4 o;
#pragma unroll
                for (int j = 0; j < 4; ++j) o[j] = ((po[j] >> 7) << 16) | ((unsigned)(int)__builtin_rintf(av[j] * qs) & 0xffu);
                *(u32x4*)(pka + (size_t)grp * 1024 + 256 * q + 4 * lane) = o;
                if ((lane & 31) == 0) asc[grp * 8 + 2 * q + (lane >> 5)] = mx * (1.f / (127.f * V8_SCALE));
            }
            G8_SCHED();
        }
        if (!has) break;
        grp = ngrp; s4 = ns4; bufo ^= 1024; deq = deqn; Ub = Un;
    }
#undef GU_LOADA
#undef GU_WRITEA
#undef GU_COMPUTE
}
__device__ __forceinline__ void gatherV_phase(LAS unsigned char* lds, const bf16* xin, const unsigned char* Vs, const unsigned* pka, const float* asc, float* xout, bf16* xbout, unsigned char* xqout, u64* ssq_out,
                                              const XcdPart& X, int lane, int wave) {
    const int g = lane >> 3, c = lane & 7, nw = X.nw; const unsigned c16 = (unsigned)c * 16u;
    LAS unsigned* aL = (LAS unsigned*)(lds + wave * 16384);
    LAS unsigned* bL = (LAS unsigned*)(lds + wave * 16384 + 6144);
    LAS float* yL = (LAS float*)(lds + wave * 16384 + 2048);
    LAS unsigned* oL = (LAS unsigned*)(lds + wave * 16384 + 8192);
    for (int sl = X.s0; sl < 8; sl += X.ns) {
        const unsigned char* Vb = Vs + (size_t)sl * 16384 * 128;
        int grp = X.wr; if (grp >= T / 8) continue;
        u32x4 oq[4]; u32x4 urA[8], urB[8]; int acc[16];
#define GV_LOADA(gg) do { _Pragma("unroll") for (int _q = 0; _q < 4; ++_q) oq[_q] = *(const u32x4*)(pka + (size_t)(gg) * 1024 + 256 * _q + 4 * lane); } while (0)
#define GV_WRITEA(bufo) do { _Pragma("unroll") for (int _q = 0; _q < 4; ++_q) { u32x4 _o; \
            _Pragma("unroll") for (int _j = 0; _j < 4; ++_j) _o[_j] = (oq[_q][_j] >> 16) << 7; \
            *(LAS u32x4*)(oL + (bufo) + 256 * _q + 4 * lane) = _o; \
            aL[((bufo) >> 2) + 64 * _q + lane] = (oq[_q][0] & 0xffu) | ((oq[_q][1] & 0xffu) << 8) | ((oq[_q][2] & 0xffu) << 16) | (oq[_q][3] << 24); } } while (0)
#define GV_COMPUTE(ur, blk) do { const u32x2 _aw = *(const LAS u32x2*)(aL + (bufo >> 2) + g * 32 + 2 * (blk)); \
            _Pragma("unroll") for (int _h = 0; _h < 2; ++_h) { const int _a4 = (int)_aw[_h]; \
                _Pragma("unroll") for (int _j = 0; _j < 4; ++_j) { const unsigned _r0 = ur[4 * _h][_j], _r1 = ur[4 * _h + 1][_j], _r2 = ur[4 * _h + 2][_j], _r3 = ur[4 * _h + 3][_j]; \
                    const unsigned _t0 = __builtin_amdgcn_perm(_r1, _r0, 0x05010400u), _t1 = __builtin_amdgcn_perm(_r1, _r0, 0x07030602u), _u0 = __builtin_amdgcn_perm(_r3, _r2, 0x05010400u), _u1 = __builtin_amdgcn_perm(_r3, _r2, 0x07030602u); \
                    acc[4 * _j] = __builtin_amdgcn_sdot4((int)__builtin_amdgcn_perm(_u0, _t0, 0x05040100u), _a4, acc[4 * _j], false); acc[4 * _j + 1] = __builtin_amdgcn_sdot4((int)__builtin_amdgcn_perm(_u0, _t0, 0x07060302u), _a4, acc[4 * _j + 1], false); \
                    acc[4 * _j + 2] = __builtin_amdgcn_sdot4((int)__builtin_amdgcn_perm(_u1, _t1, 0x05040100u), _a4, acc[4 * _j + 2], false); acc[4 * _j + 3] = __builtin_amdgcn_sdot4((int)__builtin_amdgcn_perm(_u1, _t1, 0x07060302u), _a4, acc[4 * _j + 3], false); } } } while (0)
        GV_LOADA(grp); GV_WRITEA(0);
        int bufo = 0;
        G8_LOADS(urA, Vb, oL, bufo, 0);
        for (;;) {
            const int nxt = grp + nw; const bool has = nxt < T / 8;
            if (has) GV_LOADA(nxt);
            const size_t xoff = (size_t)(grp * 8 + g) * D + 128 * sl + 16 * c;
            const float dsc = asc[grp * 8 + g];
            const bf16* xrow_in = xin + (size_t)(grp * 8 + g) * D + 128 * sl;
            const u32x4 xp0 = *(const u32x4*)(xrow_in + 8 * c), xp1 = *(const u32x4*)(xrow_in + 64 + 8 * c);
#pragma unroll
            for (int i = 0; i < 16; ++i) acc[i] = 0;
#pragma unroll 1
            for (int bp = 0; bp < 8; ++bp) {
                G8_LOADS(urB, Vb, oL, bufo, 2 * bp + 1); G8_SCHED();
                GV_COMPUTE(urA, 2 * bp); G8_SCHED();
                if (bp < 7) G8_LOADS(urA, Vb, oL, bufo, 2 * bp + 2);
                else if (has) { GV_WRITEA(bufo ^ 1024); G8_LOADS(urA, Vb, oL, bufo ^ 1024, 0); }
                G8_SCHED();
                GV_COMPUTE(urB, 2 * bp + 1); G8_SCHED();
            }
            float ss = 0.f;
            *(LAS u32x4*)(bL + g * 64 + 4 * c) = xp0; *(LAS u32x4*)(bL + g * 64 + 32 + 4 * c) = xp1;
            asm volatile("" ::: "memory");
            const u32x4 xw0 = *(const LAS u32x4*)(bL + g * 64 + 8 * c), xw1 = *(const LAS u32x4*)(bL + g * 64 + 8 * c + 4);
            asm volatile("" ::: "memory");
            u32x4 ob0, ob1, oq8;
#pragma unroll
            for (int q = 0; q < 4; ++q) {
                const unsigned wa = q < 2 ? xw0[2 * (q & 1)] : xw1[2 * (q & 1)], wb = q < 2 ? xw0[2 * (q & 1) + 1] : xw1[2 * (q & 1) + 1];
                f32x4 y; y[0] = bflo(wa) + (float)acc[4 * q] * dsc; y[1] = bfhi(wa) + (float)acc[4 * q + 1] * dsc; y[2] = bflo(wb) + (float)acc[4 * q + 2] * dsc; y[3] = bfhi(wb) + (float)acc[4 * q + 3] * dsc;
                ss += y[0] * y[0] + y[1] * y[1] + y[2] * y[2] + y[3] * y[3];
                if (xout) *(LAS f32x4*)(yL + g * 128 + 16 * c + 4 * q) = y;
                oq8[q] = pk4_fp8(y[0] * F8_XS, y[1] * F8_XS, y[2] * F8_XS, y[3] * F8_XS);
                if (q < 2) { ob0[2 * (q & 1)] = pk2(y[0], y[1]); ob0[2 * (q & 1) + 1] = pk2(y[2], y[3]); } else { ob1[2 * (q & 1)] = pk2(y[0], y[1]); ob1[2 * (q & 1) + 1] = pk2(y[2], y[3]); }
            }
            if (xbout) {
                asm volatile("" ::: "memory");
                *(LAS u32x4*)(bL + g * 64 + 8 * c) = ob0; *(LAS u32x4*)(bL + g * 64 + 8 * c + 4) = ob1;
                asm volatile("" ::: "memory");
                bf16* xrow_o = xbout + (size_t)(grp * 8 + g) * D + 128 * sl;
                *(u32x4*)(xrow_o + 8 * c) = *(const LAS u32x4*)(bL + g * 64 + 4 * c); *(u32x4*)(xrow_o + 64 + 8 * c) = *(const LAS u32x4*)(bL + g * 64 + 32 + 4 * c);
            }
            asm volatile("" ::: "memory");
            if (xout) {
                float* xrow = xout + (size_t)(grp * 8 + g) * D + 128 * sl;
#pragma unroll
                for (int q = 0; q < 4; ++q) *(f32x4*)(xrow + 32 * q + 4 * c) = *(const LAS f32x4*)(yL + g * 128 + 32 * q + 4 * c);
            }
            if (xqout) *(u32x4*)(xqout + xoff) = oq8;
            if (ssq_out) { ss += dpp_f<0xB1>(ss); ss += dpp_f<0x4E>(ss); ss += dpp_f<0x141>(ss); if (c == 0) ssq_add(ssq_out + grp * 8 + g, ss); }
            if (!has) break;
            grp = nxt; bufo ^= 1024;
        }
#undef GV_LOADA
#undef GV_WRITEA
#undef GV_COMPUTE
    }
}

#ifndef DBG_NOMIX
#define DBG_NOMIX 0
#endif
#ifndef DBG_NOPEER
#define DBG_NOPEER 0
#endif
struct Args { Ptrs p; int ph_lo, ph_hi; };
constexpr int NPHASE = 18;

__global__ void __launch_bounds__(NTHR, 2) mega_fwd(Args args) {
    extern __shared__ __attribute__((aligned(16))) unsigned char lds_raw[];
    LAS unsigned char* lds = (LAS unsigned char*)lds_raw;
    const Ptrs& P = args.p;
    unsigned char* ws = P.ws;
    const int tid = threadIdx.x, lane = tid & 63, wave = __builtin_amdgcn_readfirstlane(tid >> 6);
    volatile LAS unsigned* MISC = (volatile LAS unsigned*)(lds + MISC_OFF);
    if (tid < 32) MISC[tid] = 0u;
    __syncthreads();
    const int lo = args.ph_lo, hi = args.ph_hi;
    const bool multi = (hi - lo) > 1;
    XcdBarrier bar; bar.bar = (unsigned*)(ws + WS_CTL) + CW_BAR; bar.x = 0; bar.st = nullptr;
    if (multi) bar = xcd_barrier_post((unsigned*)(ws + WS_CTL) + CW_BAR, MISC + 8);
#ifndef PH_MASK
#define PH_MASK 0x3ffff
#endif
#define IN(k) ((((PH_MASK) >> (k)) & 1) && lo <= (k) && (k) < hi)
#define SEAM(k) do { if (IN(k) && IN((k) + 1)) xcd_barrier(bar); } while (0)
    const int G = gridDim.x, cid = blockIdx.x;
    const unsigned xcc = xb_xcc_id();
    if (tid == 0) MISC[16] = xb_add((unsigned*)(ws + WS_CTL) + CW_RANK + 64 * xcc, 1u);
    __syncthreads();
#define XCD_PART() XcdPart X; { unsigned nloc = 1, ord = 0, nx = 0; _Pragma("unroll") for (unsigned j = 0; j < 16; ++j) { const unsigned cj = xb_ld((unsigned*)(ws + WS_CTL) + CW_RANK + 64 * j); \
        nx += cj > 0u; ord += (cj > 0u && j < xcc); nloc = (j == xcc) ? cj : nloc; } \
        X.wr = (int)(MISC[16] * NWAVES) + wave; X.nw = (int)(nloc * NWAVES); X.s0 = (int)ord; X.ns = (int)(nx ? nx : 1u); }
    u64* ssq_cq = (u64*)(ws + CTL_SSQ_CQ); u64* ssq_ckv = (u64*)(ws + CTL_SSQ_CKV); u64* ssq_x1 = (u64*)(ws + CTL_SSQ_X1); u64* ssq_x3 = (u64*)(ws + CTL_SSQ_X3); u64* ssq_x2 = (u64*)(ws + CTL_SSQ_X2); u64* ssq_pe = (u64*)(ws + CTL_SSQ_PE);
    bf16* xb = (bf16*)(ws + WS_XB);
    bf16* big = (bf16*)(ws + WS_BIG);

    if (IN(0)) { p0_prologue(P, lds, tid, lane, wave); }
    SEAM(0);
    if (IN(1)) {
        pg8::Gemm g{(const bf16*)(ws + WS_XA + 32 * MiB), (const bf16*)(ws + WS_W0T), T, 1536, 512, 512, 512}; pg8::StaticOrder S; S.init(T, 1536, G, cid);
        pg8::EpiProj0 E{big, (const float*)(ws + WS_RSTD0), ssq_cq, ssq_ckv, ssq_pe, P.in[12], P.in[13], 1.f / (F8_XS * F8_WS)};
        pg8::gemm_phase<pg8::EpiProj0, true>(lds, g, S, E);
    }
    SEAM(1);
    if (IN(2)) {
        { pg8::Gemm g{big, (const bf16*)(ws + WS_WUQT), T, 768, 384, 1536, 384}; pg8::StaticOrder S; S.init(T, 768, G, cid);
          pg8::EpiPlainBf16 E{(bf16*)(ws + WS_BIG + BIG_QRAW), 768};
          pg8::gemm_phase(lds, g, S, E); }
        { pg8::Gemm g{big + 384, (const bf16*)(ws + WS_WUKVT), T, 1024, 256, 1536, 256}; pg8::StaticOrder S; S.init(T, 1024, G, cid);
          pg8::EpiKVNorm E{(bf16*)(ws + WS_ATT + ATT_KM), (bf16*)(ws + WS_ATT + ATT_VMT), big, ssq_ckv, ssq_pe, P.in[11], (const float*)(ws + WS_ROPE)};
          pg8::gemm_phase(lds, g, S, E); }
    }
    SEAM(2);
    if (IN(3)) { attn0_phase(P, lds, tid, lane, wave); }
    SEAM(3);
    if (IN(4)) {
        pg8::Gemm g{(const bf16*)(ws + WS_MIX), (const bf16*)(ws + WS_WOUT0T), T, 1024, 512, 512, 512}; pg8::StaticOrder S; S.init(T, 1024, G, cid);
        pg8::EpiResid E{xb, ws + WS_XA + 32 * MiB, ssq_x1, (DBG_NOMIX & 1) ? 0.f : 1.f / (F8_XS * F8_WS)};
        pg8::gemm_phase<pg8::EpiResid, true>(lds, g, S, E);
    }
    SEAM(4);
    if (IN(5)) {
        pg8::Gemm g{(const bf16*)(ws + WS_XA + 32 * MiB), (const bf16*)(ws + WS_WPQT), T, 2048, 512, 512, 512}; pg8::StaticOrder S; S.init(T, 2048, G, cid);
        pg8::EpiScoreT E{(unsigned*)(ws + WS_BIG), ssq_x1, 1.f / (I8_XS * I8_WS)};
        pg8::gemm_phase<pg8::EpiScoreT, false, true>(lds, g, S, E);
    }
    SEAM(5);
    if (IN(6)) { topk_phase(P, lds, tid, lane, wave, xb, ssq_x1, P.in[3], ws + WS_TAB, (DBG_NOPEER & 1) ? 0.f : 1.f); }
    SEAM(7);
    if (IN(9)) {
        XCD_PART();
        gatherV_phase(lds, xb, ws + WS_TAB + 16 * MiB, (const unsigned*)(ws + WS_PKA), (const float*)(ws + WS_EW), nullptr, xb, ws + WS_XA + 32 * MiB, ssq_x2, X, lane, wave);
    }
    SEAM(9);
    if (IN(10)) {
        pg8::Gemm g{(const bf16*)(ws + WS_XA + 32 * MiB), (const bf16*)(ws + WS_W1T), T, 3072, 512, 512, 512}; pg8::StaticOrder S; S.init(T, 3072, G, cid);
        pg8::EpiQKVNorm E{(bf16*)(ws + WS_ATT + ATT_CQ), (size_t)(32 * MiB / 2), ssq_x2, P.in[17], P.in[18], 1.f / (F8_XS * F8_WS)};
        pg8::gemm_phase<pg8::EpiQKVNorm, true>(lds, g, S, E);
    }
    SEAM(10);
    if (IN(11)) { attn1_phase(P, lds, tid, lane, wave); }
    SEAM(11);
    if (IN(12)) {
        pg8::Gemm g{(const bf16*)(ws + WS_MIX), (const bf16*)(ws + WS_WOUT1T), T, 1024, 512, 512, 512}; pg8::StaticOrder S; S.init(T, 1024, G, cid);
        pg8::EpiResid E{xb, ws + WS_XA + 32 * MiB, ssq_x3, (DBG_NOMIX & 2) ? 0.f : 1.f / (F8_XS * F8_WS)};
        pg8::gemm_phase<pg8::EpiResid, true>(lds, g, S, E);
    }
    SEAM(12);
    if (IN(13)) {
        pg8::Gemm g{(const bf16*)(ws + WS_XA + 32 * MiB), (const bf16*)(ws + WS_WPQT + (size_t)2048 * 1024), T, 2048, 512, 512, 512}; pg8::StaticOrder S; S.init(T, 2048, G, cid);
        pg8::EpiScoreT E{(unsigned*)(ws + WS_BIG), ssq_x3, 1.f / (I8_XS * I8_WS)};
        pg8::gemm_phase<pg8::EpiScoreT, false, true>(lds, g, S, E);
    }
    SEAM(13);
    if (IN(14)) { topk_phase(P, lds, tid, lane, wave, xb, ssq_x3, P.in[3] + 1024, ws + WS_TAB + 32 * MiB, (DBG_NOPEER & 2) ? 0.f : 1.f); }
    SEAM(15);
    if (IN(17)) {
        XCD_PART();
        gatherV_phase(lds, xb, ws + WS_TAB + 48 * MiB, (const unsigned*)(ws + WS_PKA), (const float*)(ws + WS_EW), P.out, nullptr, nullptr, nullptr, X, lane, wave);
    }
#undef IN
#undef SEAM
}

#ifndef MK_ONE_LAUNCH
#define MK_ONE_LAUNCH 1
#endif

extern "C" void kernel_launch(void* const* d_in, const int* in_sizes, int n_in, void* d_out, int out_size, void* d_ws, size_t ws_size, hipStream_t stream) {
    static int grid = 0;
    if (grid == 0) {
        if (n_in != 24 || in_sizes[0] != T * D || out_size != T * D || ws_size < WS_END) { fprintf(stderr, "kernel_launch: unexpected shapes (n_in %d, ws %zu)\n", n_in, ws_size); grid = -1; return; }
        int dev = 0, cus = 0, per_cu = 0;
        if (hipGetDevice(&dev) != hipSuccess || hipDeviceGetAttribute(&cus, hipDeviceAttributeMultiprocessorCount, dev) != hipSuccess) { grid = -1; return; }
        if (hipFuncSetAttribute((const void*)mega_fwd, hipFuncAttributeMaxDynamicSharedMemorySize, LDS_BYTES) != hipSuccess) { fprintf(stderr, "kernel_launch: hipFuncSetAttribute failed\n"); grid = -1; return; }
        if (hipOccupancyMaxActiveBlocksPerMultiprocessor(&per_cu, (const void*)mega_fwd, NTHR, LDS_BYTES) != hipSuccess || per_cu < 1) { fprintf(stderr, "kernel_launch: occupancy query says %d blocks per CU\n", per_cu); }
        (void)hipGetLastError();
        grid = cus;
    }
    if (grid < 0) return;
    if (hipMemsetAsync((char*)d_ws + WS_CTL, 0, CTL_ZERO_BYTES, stream) != hipSuccess) return;
    Args a{};
    for (int i = 0; i < 24; ++i) a.p.in[i] = (const float*)d_in[i];
    a.p.out = (float*)d_out; a.p.ws = (unsigned char*)d_ws;
#if MK_ONE_LAUNCH
    a.ph_lo = 0; a.ph_hi = NPHASE;
    hipLaunchKernelGGL(mega_fwd, dim3(grid), dim3(NTHR), LDS_BYTES, stream, a);
#else
    for (int ph = 0; ph < NPHASE; ++ph) { a.ph_lo = ph; a.ph_hi = ph + 1; hipLaunchKernelGGL(mega_fwd, dim3(grid), dim3(NTHR), LDS_BYTES, stream, a); }
#endif
}
```
